# Optimizing an MI355X kernel written in HIP

```python
import math
import jax, jax.numpy as jnp
from jax import lax
import numpy as np

D_MODEL = 4096
BATCH = 8
SEQ = 2048
DEPTH = 2

N_A = DEPTH // 2
N_B = DEPTH - N_A
HEAD_DIM = 128
POOL_WINDOWS = (2, 4, 8, 16)
N_POOL_GROUPS = 4
POOL_WIDTH = 3 * D_MODEL // 4
POOL_GROUP = POOL_WIDTH // N_POOL_GROUPS
MEM_LEN = 256
MEM_HEADS = 4
MEM_HEAD_DIM = D_MODEL // 16
MEM_WIDTH = MEM_HEADS * MEM_HEAD_DIM
DIL_CONFIGS = ((128, 1), (512, 4), (2048, 16))
N_DIL_GROUPS = len(DIL_CONFIGS)
DIL_HEADS = D_MODEL // 512
DIL_Q_WIDTH = N_DIL_GROUPS * DIL_HEADS * HEAD_DIM
DIL_OUT_WIDTH = DIL_HEADS * HEAD_DIM
KV_WIDTH = 2 * DIL_Q_WIDTH
A_IN_WIDTH = POOL_WIDTH + MEM_WIDTH
A_OUT_WIDTH = POOL_WIDTH + MEM_WIDTH
B_IN_WIDTH = DIL_Q_WIDTH + MEM_WIDTH
B_OUT_WIDTH = DIL_OUT_WIDTH + MEM_WIDTH
D_FF = 4 * D_MODEL
NUM_BUCKETS = 32
MAX_DISTANCE = 2048
EPS = 1e-6

kernel_name = "yoco_pool_dilated_hybrid"


def rmsnorm(x, g):
    x32 = x.astype(jnp.float32)
    y = x32 * lax.rsqrt(jnp.mean(x32 * x32, axis=-1, keepdims=True) + EPS)
    return (y * g.astype(jnp.float32)).astype(x.dtype)


def sq_relu_mlp(h, w1, w2):
    a = jax.nn.relu(h @ w1)
    return (a * a) @ w2


def t5_bucket(dist):
    max_exact = NUM_BUCKETS // 2
    d32 = jnp.maximum(dist, 1).astype(jnp.float32)
    large = max_exact + (jnp.log(d32 / max_exact) / math.log(MAX_DISTANCE / max_exact)
                         * (NUM_BUCKETS - max_exact)).astype(jnp.int32)
    large = jnp.minimum(large, NUM_BUCKETS - 1)
    return jnp.where(dist < max_exact, dist, large)


def pool_mixer(u, w_pg, scale):
    b, s, _ = u.shape
    ug = u.reshape(b, s, N_POOL_GROUPS, POOL_GROUP).astype(jnp.float32)
    cs = jnp.cumsum(ug, axis=1)
    pos = jnp.arange(s)
    outs = []
    for g, w in enumerate(POOL_WINDOWS):
        c = cs[:, :, g]
        lag = jnp.pad(c, ((0, 0), (w, 0), (0, 0)))[:, :s]
        cnt = jnp.minimum(pos + 1, w).astype(jnp.float32)[None, :, None]
        outs.append((c - lag) / cnt - ug[:, :, g])
    pooled = jnp.stack(outs, axis=2).astype(u.dtype)
    mixed = jnp.einsum('bsgc,gcd->bsgd', pooled, w_pg).reshape(b, s, POOL_WIDTH)
    return mixed * scale


def memory_attention(u_mem, mk, mv):
    b, s, _ = u_mem.shape
    q = u_mem.reshape(b, s, MEM_HEADS, MEM_HEAD_DIM)
    logits = jnp.einsum('bshc,bmhc->bhsm', q, mk).astype(jnp.float32) / math.sqrt(MEM_HEAD_DIM)
    p = jax.nn.softmax(logits, axis=-1).astype(mv.dtype)
    o = jnp.einsum('bhsm,bmhc->bshc', p, mv)
    return o.reshape(b, s, MEM_WIDTH)


def dilated_group(q, k, v, window, dil, bias_g):
    b, s, h, hd = q.shape
    wd = window // dil
    blk = wd
    L = s // dil
    nblk = -(-L // blk)
    lp = nblk * blk

    def to_blocks(t):
        t = t.reshape(b, L, dil, h, hd).transpose(0, 3, 2, 1, 4)
        t = jnp.pad(t, ((0, 0), (0, 0), (0, 0), (0, lp - L), (0, 0)))
        return t.reshape(b, h, dil, nblk, blk, hd)

    def with_prev(t):
        prev = jnp.pad(t, ((0, 0), (0, 0), (0, 0), (1, 0), (0, 0), (0, 0)))[:, :, :, :nblk]
        return jnp.concatenate([prev, t], axis=4)

    qb = to_blocks(q)
    kk = with_prev(to_blocks(k))
    vv = with_prev(to_blocks(v))

    qi = jnp.arange(blk)[:, None]
    kj = jnp.arange(2 * blk)[None, :]
    delta = qi + blk - kj
    band = (delta >= 0) & (delta <= wd)
    first = (jnp.arange(nblk)[:, None, None] == 0) & (kj[None] < blk)
    valid = band[None] & ~first
    bucket = t5_bucket(jnp.maximum(delta, 0) * dil)
    bias = bias_g[bucket].astype(jnp.float32).transpose(2, 0, 1)

    logits = jnp.einsum('bhrnqc,bhrnkc->bhrnqk', qb, kk).astype(jnp.float32) / math.sqrt(hd)
    logits = logits + bias[None, :, None, None]
    logits = jnp.where(valid[None, None, None], logits, -jnp.inf)
    m = jnp.max(logits, axis=-1, keepdims=True)
    p = jnp.exp(logits - m)
    den = jnp.sum(p, axis=-1, keepdims=True)
    o = jnp.einsum('bhrnqk,bhrnkc->bhrnqc', (p / den).astype(v.dtype), vv)
    lse = (m + jnp.log(den))[..., 0]

    o = o.reshape(b, h, dil, lp, hd)[:, :, :, :L].transpose(0, 3, 2, 1, 4).reshape(b, s, h, hd)
    lse = lse.reshape(b, h, dil, lp)[..., :L].transpose(0, 3, 2, 1).reshape(b, s, h)
    return o, lse


def dilated_attention(q, k, v, rel_bias):
    b, s = q.shape[:2]
    outs, lses = [], []
    for g, (window, dil) in enumerate(DIL_CONFIGS):
        bias_g = rel_bias[:, g * DIL_HEADS:(g + 1) * DIL_HEADS]
        o, lse = dilated_group(q[:, :, g], k[:, :, g], v[:, :, g], window, dil, bias_g)
        outs.append(o)
        lses.append(lse)
    wgt = jax.nn.softmax(jnp.stack(lses, axis=-1), axis=-1)
    o = jnp.stack(outs, axis=-1).astype(jnp.float32)
    o = jnp.sum(o * wgt[:, :, :, None, :], axis=-1).astype(q.dtype)
    return o.reshape(b, s, DIL_OUT_WIDTH)


def setup_inputs(seed: int = 0) -> dict:
    key = jax.random.key(seed)
    ks = jax.random.split(key, 24)
    f32 = jnp.float32

    def nrm(k, shape, fan_in):
        return jax.random.normal(k, shape, f32) * (fan_in ** -0.5)

    def gain(k, shape):
        return 1.0 + 0.02 * jax.random.normal(k, shape, f32)

    return {
        "x": jax.random.normal(ks[0], (BATCH, SEQ, D_MODEL), f32),
        "mem": jax.random.normal(ks[1], (BATCH, MEM_LEN, D_MODEL), f32),
        "a_norm": gain(ks[2], (N_A, D_MODEL)),
        "a_w_in": nrm(ks[3], (N_A, D_MODEL, A_IN_WIDTH), D_MODEL),
        "a_w_pg": nrm(ks[4], (N_A, N_POOL_GROUPS, POOL_GROUP, POOL_GROUP), POOL_GROUP),
        "a_scale": gain(ks[5], (N_A, POOL_WIDTH)),
        "a_w_out": nrm(ks[6], (N_A, A_OUT_WIDTH, D_MODEL), A_OUT_WIDTH),
        "kv_norm": gain(ks[7], (D_MODEL,)),
        "w_kv": nrm(ks[8], (D_MODEL, KV_WIDTH), D_MODEL),
        "b_norm": gain(ks[9], (N_B, D_MODEL)),
        "b_w_in": nrm(ks[10], (N_B, D_MODEL, B_IN_WIDTH), D_MODEL),
        "b_w_out": nrm(ks[11], (N_B, B_OUT_WIDTH, D_MODEL), B_OUT_WIDTH),
        "mem_norm": gain(ks[12], (D_MODEL,)),
        "w_mem_kv": nrm(ks[13], (DEPTH, D_MODEL, 2 * MEM_WIDTH), D_MODEL),
        "mlp_norm": gain(ks[14], (DEPTH, D_MODEL)),
        "mlp_w1": nrm(ks[15], (DEPTH, D_MODEL, D_FF), D_MODEL),
        "mlp_w2": nrm(ks[16], (DEPTH, D_FF, D_MODEL), D_FF),
        "rel_bias": 0.2 * jax.random.normal(ks[17], (NUM_BUCKETS, N_DIL_GROUPS * DIL_HEADS), f32),
        "final_norm": gain(ks[18], (D_MODEL,)),
    }


def reference(x, mem, a_norm, a_w_in, a_w_pg, a_scale, a_w_out, kv_norm, w_kv,
              b_norm, b_w_in, b_w_out, mem_norm, w_mem_kv, mlp_norm, mlp_w1, mlp_w2,
              rel_bias, final_norm):
    b, s, _ = x.shape
    mem_h = rmsnorm(mem, mem_norm)
    k_sh = None
    v_sh = None
    for l in range(DEPTH):
        mkv = (mem_h @ w_mem_kv[l]).reshape(b, MEM_LEN, 2, MEM_HEADS, MEM_HEAD_DIM)
        mk, mv = mkv[:, :, 0], mkv[:, :, 1]
        if l < N_A:
            h = rmsnorm(x, a_norm[l])
            u = h @ a_w_in[l]
            pool_out = pool_mixer(u[..., :POOL_WIDTH], a_w_pg[l], a_scale[l])
            mem_out = memory_attention(u[..., POOL_WIDTH:], mk, mv)
            x = x + jnp.concatenate([pool_out, mem_out], axis=-1) @ a_w_out[l]
        else:
            i = l - N_A
            if i == 0:
                kv = (rmsnorm(x, kv_norm) @ w_kv).reshape(b, s, 2, N_DIL_GROUPS, DIL_HEADS, HEAD_DIM)
                k_sh, v_sh = kv[:, :, 0], kv[:, :, 1]
            h = rmsnorm(x, b_norm[i])
            u = h @ b_w_in[i]
            q = u[..., :DIL_Q_WIDTH].reshape(b, s, N_DIL_GROUPS, DIL_HEADS, HEAD_DIM)
            dil_out = dilated_attention(q, k_sh, v_sh, rel_bias)
            mem_out = memory_attention(u[..., DIL_Q_WIDTH:], mk, mv)
            x = x + jnp.concatenate([dil_out, mem_out], axis=-1) @ b_w_out[i]
        x = x + sq_relu_mlp(rmsnorm(x, mlp_norm[l]), mlp_w1[l], mlp_w2[l])
    return rmsnorm(x, final_norm)
```

```cpp
#include <hip/hip_runtime.h>
#include <cstdio>
#include <cstdint>

#ifndef MK_PER_PHASE
#define MK_PER_PHASE 0
#endif

__device__ __forceinline__ int lane_id() { unsigned m = ~0u; asm volatile("" : "+s"(m)); return (int)__builtin_amdgcn_mbcnt_hi(m, __builtin_amdgcn_mbcnt_lo(m, 0u)); }
namespace pg8 {
#define PG8_LAS __attribute__((address_space(3)))
typedef unsigned short bf16_t;
typedef short bf16x8 __attribute__((ext_vector_type(8)));
typedef float f32x4 __attribute__((ext_vector_type(4)));
typedef unsigned u32x4 __attribute__((ext_vector_type(4)));
constexpr int BM = 256, BK = 64, HALF = 128, HTB = HALF * BK * 2  , STAGE_BYTES = 8 * HTB, NXCD = 8, WGM = 8;

__host__ __device__ __forceinline__ int lds_byte(int r, int c) { const int st = (r >> 4) * 2 + (c >> 5), rr = r & 15, cc = c & 31, ob = rr * 64 + cc * 2; return st * 1024 + (ob ^ (((ob >> 9) & 1) << 5)); }
__host__ __device__ __forceinline__ void stage_rc(int b, int& R, int& C) { const int st = b / 1024, sb = b % 1024, swz = sb ^ (((sb >> 9) & 1) << 5); R = (st >> 1) * 16 + swz / 64; C = (st & 1) * 32 + (swz % 64) / 2; }
__host__ __device__ __forceinline__ int perm32(int rho) { const int n = rho >> 4, i = rho & 15; return 8 * (i >> 2) + 4 * n + (i & 3); }

struct Unit { int pm, pn; };
struct Gemm { const bf16_t* A; const bf16_t* Bt; int M, N, K, lda, ldb, npg, a_gstride; };

struct StaticOrder {
    int nM, nN, nwg, G, c;
    __host__ __device__ void init(int M, int N, int G_, int c_) { nM = M / BM; nN = N / BM; nwg = nM * nN; G = G_; c = c_; }
    __host__ __device__ bool next(int i, Unit& u) const {
        const long L = (long)i * G + c; if (L >= nwg) return false;
        int wgid = (int)L; { const int q = nwg / NXCD, r = nwg % NXCD, xcd = wgid % NXCD, off = wgid / NXCD; wgid = (xcd < r ? xcd * (q + 1) : r * (q + 1) + (xcd - r) * q) + off; }
        const int nig = WGM * nN, gid = wgid / nig, fm = gid * WGM, gsz = (nM - fm) < WGM ? (nM - fm) : WGM;
        u.pm = fm + ((wgid % nig) % gsz); u.pn = (wgid % nig) / gsz; return true;
    }
    __device__ __forceinline__ void a_ready(const Unit&) const {}
    __device__ __forceinline__ void done(const Unit&) const {}
};

__device__ __forceinline__ unsigned cvt_pk_bf16(float lo, float hi) { unsigned r; asm volatile("v_cvt_pk_bf16_f32 %0, %1, %2" : "=v"(r) : "v"(lo), "v"(hi)); return r; }

constexpr float RMS_EPS = 1e-6f;
typedef unsigned long long ssq_t;
constexpr float SSQ_SCALE = 1048576.0f, SSQ_TO_MEAN = 1.0f / (1048576.0f * 4096.0f);
__device__ __forceinline__ ssq_t ssq_from(float s) { return (ssq_t)(s * SSQ_SCALE + 0.5f); }
__device__ __forceinline__ float rstd_of(ssq_t s) { return __builtin_amdgcn_rsqf((float)s * SSQ_TO_MEAN + RMS_EPS); }
typedef int i32x4 __attribute__((ext_vector_type(4)));
constexpr float I8_SW2 = 127.0f * 128.0f / 4.0f;
constexpr float I8_SW = 127.0f * 64.0f / 4.0f;
constexpr float I8_SA = 127.0f / 4.0f;
constexpr float X2_RMS_RATIO = 1.40f;
__device__ __forceinline__ float rms_of(ssq_t s) { return __builtin_sqrtf((float)s * SSQ_TO_MEAN + RMS_EPS); }
__device__ __forceinline__ unsigned q8(float v) { return (unsigned)(int)__builtin_rintf(__builtin_amdgcn_fmed3f(v, -127.0f, 127.0f)) & 255u; }
__device__ __forceinline__ unsigned pack_q8(float a, float b, float c, float d) { return q8(a) | (q8(b) << 8) | (q8(c) << 16) | (q8(d) << 24); }
constexpr int EV_MAX = 8;
constexpr float HQ_R = 17.0f;
template <int ACT, bool IACC = false, int OQ = 0> struct EpiScaleBf16 {
    static constexpr bool PERM = true, AFTER_DRAIN = false, CINIT = false;
    int* evcnt; int* ev;
    bf16_t* O; int ldc; const ssq_t* ss; float mul; const ssq_t* ssq;
    __device__ __forceinline__ void operator()(const f32x4 (&acc)[2][2][4][2], const Unit& u, int wr, int wc, int fr, int fq) const {
        const int row0 = u.pm * BM + wr * 64 + fr, col0 = u.pn * BM + wc * 32 + 8 * fq;
        float rs[2][4];
#pragma unroll
        for (int ai = 0; ai < 2; ++ai)
#pragma unroll
            for (int m = 0; m < 4; ++m) { rs[ai][m] = (ss ? rstd_of(ss[row0 + ai * HALF + m * 16]) : 1.0f) * mul;
                if constexpr (IACC) { if (ssq) rs[ai][m] *= rms_of(ssq[row0 + ai * HALF + m * 16]); } }
#pragma unroll
        for (int ai = 0; ai < 2; ++ai)
#pragma unroll
            for (int m = 0; m < 4; ++m) { bf16_t* rowp = O + (size_t)(row0 + ai * HALF + m * 16) * ldc + col0; const float r = rs[ai][m];
#pragma unroll
                for (int bj = 0; bj < 2; ++bj) { f32x4 v0, v1;
                    if constexpr (IACC) { const i32x4 i0 = __builtin_bit_cast(i32x4, acc[ai][bj][m][0]), i1 = __builtin_bit_cast(i32x4, acc[ai][bj][m][1]);
                        v0 = (f32x4){(float)i0[0], (float)i0[1], (float)i0[2], (float)i0[3]} * r; v1 = (f32x4){(float)i1[0], (float)i1[1], (float)i1[2], (float)i1[3]} * r; }
                    else { v0 = acc[ai][bj][m][0] * r; v1 = acc[ai][bj][m][1] * r; }
                    if (ACT == 1) {
#pragma unroll
                        for (int j = 0; j < 4; ++j) { const float a = fmaxf(v0[j], 0.f), b = fmaxf(v1[j], 0.f); v0[j] = a * a; v1[j] = b * b; } }
                    if constexpr (OQ == 1) { typedef unsigned v2u_t __attribute__((ext_vector_type(2))); constexpr float s = 255.0f / HQ_R;
#define PG8_HQ(v) ((unsigned)(int)__builtin_rintf(__builtin_fminf((v) * s, 255.0f)))
                        const unsigned q0 = (PG8_HQ(v0[0]) | (PG8_HQ(v0[1]) << 8) | (PG8_HQ(v0[2]) << 16) | (PG8_HQ(v0[3]) << 24)) ^ 0x80808080u;
                        const unsigned q1 = (PG8_HQ(v1[0]) | (PG8_HQ(v1[1]) << 8) | (PG8_HQ(v1[2]) << 16) | (PG8_HQ(v1[3]) << 24)) ^ 0x80808080u;
#undef PG8_HQ
                        *(v2u_t*)((unsigned char*)O + (size_t)(row0 + ai * HALF + m * 16) * ldc + col0 + bj * HALF) = (v2u_t){q0, q1};
                        const float vmx = fmaxf(fmaxf(fmaxf(v0[0], v0[1]), fmaxf(v0[2], v0[3])), fmaxf(fmaxf(v1[0], v1[1]), fmaxf(v1[2], v1[3])));
                        if (vmx > HQ_R) {
                            const int row = row0 + ai * HALF + m * 16;
#pragma unroll
                            for (int j = 0; j < 8; ++j) { const float v = j < 4 ? v0[j & 3] : v1[j & 3];
                                if (v > HQ_R) { const int idx = __hip_atomic_fetch_add(evcnt + row, 1, __ATOMIC_RELAXED, __HIP_MEMORY_SCOPE_AGENT);
                                    if (idx < EV_MAX) { typedef int v2i_t __attribute__((ext_vector_type(2))); *(v2i_t*)(ev + ((size_t)row * EV_MAX + idx) * 2) = (v2i_t){col0 + bj * HALF + j, __builtin_bit_cast(int, v - HQ_R)}; } } }
                        }
                    } else {
                    u32x4 w; w.x = cvt_pk_bf16(v0[0], v0[1]); w.y = cvt_pk_bf16(v0[2], v0[3]); w.z = cvt_pk_bf16(v1[0], v1[1]); w.w = cvt_pk_bf16(v1[2], v1[3]);
                    *(u32x4*)(rowp + bj * HALF) = w; } } }
    }
};
template <int XQ = 0, bool IACC = false> struct EpiResid {
    static constexpr bool PERM = true, AFTER_DRAIN = false, CINIT = IACC;
    const bf16_t* xin; bf16_t* xout; ssq_t* ss; unsigned char* x8; float mul; const ssq_t* qss; float qmul; const int* cs;
    __device__ __forceinline__ void init_acc(f32x4 (&acc)[2][2][4][2], const Unit& u, int wc, int fq) const {
#pragma unroll
        for (int bj = 0; bj < 2; ++bj)
#pragma unroll
            for (int n = 0; n < 2; ++n) { const i32x4 c = *(const i32x4*)(cs + u.pn * BM + bj * HALF + wc * 32 + 8 * fq + 4 * n);
#pragma unroll
                for (int ai = 0; ai < 2; ++ai)
#pragma unroll
                    for (int m = 0; m < 4; ++m) acc[ai][bj][m][n] = __builtin_bit_cast(f32x4, c); }
    }
    __device__ __forceinline__ void operator()(const f32x4 (&acc)[2][2][4][2], const Unit& u, int wr, int wc, int fr, int fq) const {
        const int row0 = u.pm * BM + wr * 64 + fr, col0 = u.pn * BM + wc * 32 + 8 * fq;
#pragma unroll
        for (int ai = 0; ai < 2; ++ai) {
            u32x4 xr[4][2];
#pragma unroll
            for (int m = 0; m < 4; ++m)
#pragma unroll
                for (int bj = 0; bj < 2; ++bj) xr[m][bj] = *(const u32x4*)(xin + (size_t)(row0 + ai * HALF + m * 16) * 4096 + col0 + bj * HALF);
#pragma unroll
            for (int m = 0; m < 4; ++m) { const int row = row0 + ai * HALF + m * 16; const size_t off = (size_t)row * 4096 + col0; float sq = 0.f;
                float qs = 0.f; if constexpr (XQ == 2) qs = rstd_of(qss[row]) * qmul;
#pragma unroll
                for (int bj = 0; bj < 2; ++bj) { const u32x4 x = xr[m][bj];
                    const f32x4 a0 = {__builtin_bit_cast(float, x.x << 16), __builtin_bit_cast(float, x.x & 0xffff0000u), __builtin_bit_cast(float, x.y << 16), __builtin_bit_cast(float, x.y & 0xffff0000u)};
                    const f32x4 a1 = {__builtin_bit_cast(float, x.z << 16), __builtin_bit_cast(float, x.z & 0xffff0000u), __builtin_bit_cast(float, x.w << 16), __builtin_bit_cast(float, x.w & 0xffff0000u)};
                    f32x4 c0, c1;
                    if constexpr (IACC) { const i32x4 i0 = __builtin_bit_cast(i32x4, acc[ai][bj][m][0]), i1 = __builtin_bit_cast(i32x4, acc[ai][bj][m][1]);
                        c0 = (f32x4){(float)i0[0], (float)i0[1], (float)i0[2], (float)i0[3]}; c1 = (f32x4){(float)i1[0], (float)i1[1], (float)i1[2], (float)i1[3]}; }
                    else { c0 = acc[ai][bj][m][0]; c1 = acc[ai][bj][m][1]; }
                    const f32x4 v0 = c0 * mul + a0, v1 = c1 * mul + a1;
                    u32x4 w; w.x = cvt_pk_bf16(v0[0], v0[1]); w.y = cvt_pk_bf16(v0[2], v0[3]); w.z = cvt_pk_bf16(v1[0], v1[1]); w.w = cvt_pk_bf16(v1[2], v1[3]); *(u32x4*)(xout + off + bj * HALF) = w;
                    if constexpr (XQ == 2) { typedef unsigned v2u_t __attribute__((ext_vector_type(2)));
                        *(v2u_t*)(x8 + off + bj * HALF) = (v2u_t){pack_q8(v0[0] * qs, v0[1] * qs, v0[2] * qs, v0[3] * qs), pack_q8(v1[0] * qs, v1[1] * qs, v1[2] * qs, v1[3] * qs)}; }
                    if constexpr (XQ == 1) { int p0 = __builtin_amdgcn_cvt_pk_fp8_f32(v0[0], v0[1], 0, false); p0 = __builtin_amdgcn_cvt_pk_fp8_f32(v0[2], v0[3], p0, true);
                        int p1 = __builtin_amdgcn_cvt_pk_fp8_f32(v1[0], v1[1], 0, false); p1 = __builtin_amdgcn_cvt_pk_fp8_f32(v1[2], v1[3], p1, true);
                        typedef int v2i_t __attribute__((ext_vector_type(2))); *(v2i_t*)(x8 + off + bj * HALF) = (v2i_t){p0, p1}; }
                    sq += (v0[0] * v0[0] + v0[1] * v0[1]) + (v0[2] * v0[2] + v0[3] * v0[3]) + (v1[0] * v1[0] + v1[1] * v1[1]) + (v1[2] * v1[2] + v1[3] * v1[3]); }
                sq += __shfl_xor(sq, 16); sq += __shfl_xor(sq, 32);
                if (fq == 0) __hip_atomic_fetch_add(ss + row, ssq_from(sq), __ATOMIC_RELAXED, __HIP_MEMORY_SCOPE_AGENT); }
            asm volatile("" ::: "memory");
        }
    }
};

typedef int v4i_t __attribute__((ext_vector_type(4)));
typedef int v8i_t __attribute__((ext_vector_type(8)));
__device__ __forceinline__ v8i_t cat8(const bf16x8 lo, const bf16x8 hi) { return __builtin_shufflevector(__builtin_bit_cast(v4i_t, lo), __builtin_bit_cast(v4i_t, hi), 0, 1, 2, 3, 4, 5, 6, 7); }
template <class Epi, class Sched, bool ALIGN_EPI = false, bool SP2 = false, bool F8 = false, bool I8 = false>
__device__ __forceinline__ void gemm_phase(PG8_LAS unsigned char* lds, const Gemm g, const Sched& S, const Epi& E, const int wid  ) {
    const int lane = lane_id(), tid = wid * 64 + lane, wr = wid >> 2, wc = wid & 3, fr = lane & 15, fq = lane >> 4;
    const int K = g.K, nt = K / BK;
    unsigned voffA[2], voffB[2];
#pragma unroll
    for (int i = 0; i < 2; ++i) { int R, C; stage_rc(tid * 16 + i * 8192, R, C); const int Rb = Epi::PERM ? ((R & ~31) + perm32(R & 31)) : R;
        voffA[i] = (unsigned)(R * g.lda + C) * 2u; voffB[i] = (unsigned)(Rb * g.ldb + C) * 2u; }
    const size_t kstep = (size_t)(BK * 2);
    const size_t hstepA = (size_t)HALF * g.lda * 2, hstepB = (size_t)HALF * g.ldb * 2;
    const size_t tstepA = 2 * hstepA, tstepB = 2 * hstepB;
    const unsigned ldsw = (unsigned)wid * 1024u;
    const int aoff = lds_byte(wr * 64 + fr, fq * 8), boff = lds_byte(wc * 32 + fr, fq * 8);
#define PG8_SA(b, h) (((b) * 2 + (h)) * HTB)
#define PG8_SB(b, h) ((4 + (b) * 2 + (h)) * HTB)
#define PG8_STAGE(bufoff, gbase, voff) do { _Pragma("unroll") for (int _i = 0; _i < 2; ++_i) \
        __builtin_amdgcn_global_load_lds((const unsigned*)((const char*)(gbase) + (voff)[_i]), (PG8_LAS unsigned*)(lds + (bufoff) + ldsw + _i * 8192), 16, 0, 0); } while (0)
#define PG8_LDA(dst, b, h) do { _Pragma("unroll") for (int m = 0; m < 4; ++m) { \
        if constexpr (F8) dst##8[m] = cat8(*(const PG8_LAS bf16x8*)(lds + PG8_SA(b, h) + aoff + m * 2048), *(const PG8_LAS bf16x8*)(lds + PG8_SA(b, h) + aoff + m * 2048 + 1024)); \
        else { _Pragma("unroll") for (int k = 0; k < 2; ++k) dst[m][k] = *(const PG8_LAS bf16x8*)(lds + PG8_SA(b, h) + aoff + m * 2048 + k * 1024); } } } while (0)
#define PG8_LDB(dst, b, h) do { _Pragma("unroll") for (int n = 0; n < 2; ++n) { \
        if constexpr (F8) dst##8[n] = cat8(*(const PG8_LAS bf16x8*)(lds + PG8_SB(b, h) + boff + n * 2048), *(const PG8_LAS bf16x8*)(lds + PG8_SB(b, h) + boff + n * 2048 + 1024)); \
        else { _Pragma("unroll") for (int k = 0; k < 2; ++k) dst[n][k] = *(const PG8_LAS bf16x8*)(lds + PG8_SB(b, h) + boff + n * 2048 + k * 1024); } } } while (0)
#define PG8_MMA(ai, bj, At, Bt) do { __builtin_amdgcn_s_setprio(1); \
        if constexpr (F8) { _Pragma("unroll") for (int m = 0; m < 4; ++m) _Pragma("unroll") for (int n = 0; n < 2; ++n) \
            asm volatile("v_mfma_scale_f32_16x16x128_f8f6f4 %0, %1, %2, %0, %3, %3 op_sel_hi:[0,0,0]" : "+v"(acc[ai][bj][m][n]) : "v"(Bt##8[n]), "v"(At##8[m]), "v"(one_scale)); } \
        else if constexpr (I8) { _Pragma("unroll") for (int m = 0; m < 4; ++m) _Pragma("unroll") for (int n = 0; n < 2; ++n) _Pragma("unroll") for (int k = 0; k < 2; ++k) \
            acc[ai][bj][m][n] = __builtin_bit_cast(f32x4, __builtin_amdgcn_mfma_i32_16x16x64_i8(__builtin_bit_cast(v4i_t, Bt[n][k]), __builtin_bit_cast(v4i_t, At[m][k]), __builtin_bit_cast(v4i_t, acc[ai][bj][m][n]), 0, 0, 0)); } \
        else { _Pragma("unroll") for (int m = 0; m < 4; ++m) _Pragma("unroll") for (int n = 0; n < 2; ++n) _Pragma("unroll") for (int k = 0; k < 2; ++k) \
            acc[ai][bj][m][n] = __builtin_amdgcn_mfma_f32_16x16x32_bf16(Bt[n][k], At[m][k], acc[ai][bj][m][n], 0, 0, 0); } \
        __builtin_amdgcn_s_setprio(0); } while (0)
#define PG8_WAIT_V(n) asm volatile("s_waitcnt vmcnt(" #n ")" ::: "memory")
#define PG8_WAIT_L(n) asm volatile("s_waitcnt lgkmcnt(" #n ")" ::: "memory")
#define PG8_BAR __builtin_amdgcn_s_barrier()
#define PG8_SCHED __builtin_amdgcn_sched_barrier(0)
#define PG8_ABASE(u) ((const char*)g.A + (size_t)(u).pm * tstepA + (g.npg ? (size_t)((u).pn / g.npg) * (size_t)g.a_gstride : (size_t)0))
    Unit cur, nxt; int ui = 0;
    if (!S.next(0, cur)) return;
    f32x4 acc[2][2][4][2];
    if constexpr (Epi::CINIT) E.init_acc(acc, cur, wc, fq);
    else {
#pragma unroll
    for (int a = 0; a < 2; ++a)
#pragma unroll
        for (int b = 0; b < 2; ++b)
#pragma unroll
            for (int m = 0; m < 4; ++m)
#pragma unroll
                for (int n = 0; n < 2; ++n) acc[a][b][m][n] = (f32x4){0.f, 0.f, 0.f, 0.f};
    }
    bf16x8 At[4][2], B0[2][2], B1[2][2];
    v8i_t At8[4], B08[2], B18[2];
    const int one_scale = 0x7F7F7F7F;
    const char* cA = PG8_ABASE(cur); const char* cB = (const char*)g.Bt + (size_t)cur.pn * tstepB;
    S.a_ready(cur);
    if constexpr (SP2) {
        PG8_STAGE(PG8_SB(0, 0), cB, voffB); PG8_STAGE(PG8_SB(0, 1), cB + hstepB, voffB); PG8_STAGE(PG8_SA(0, 0), cA, voffA); PG8_STAGE(PG8_SA(0, 1), cA + hstepA, voffA);
        if (wr == 1) PG8_BAR;
        PG8_WAIT_V(2); PG8_BAR;
        PG8_STAGE(PG8_SB(1, 0), cB + kstep, voffB); PG8_STAGE(PG8_SA(1, 0), cA + kstep, voffA); PG8_STAGE(PG8_SB(1, 1), cB + hstepB + kstep, voffB);
        PG8_WAIT_V(6); PG8_BAR;
    } else {
        PG8_STAGE(PG8_SB(0, 0), cB, voffB); PG8_STAGE(PG8_SA(0, 0), cA, voffA); PG8_STAGE(PG8_SB(0, 1), cB + hstepB, voffB); PG8_STAGE(PG8_SA(0, 1), cA + hstepA, voffA);
        if (wr == 1) PG8_BAR;
        PG8_WAIT_V(4); PG8_BAR;
        PG8_STAGE(PG8_SB(1, 0), cB + kstep, voffB); PG8_STAGE(PG8_SA(1, 0), cA + kstep, voffA); PG8_STAGE(PG8_SB(1, 1), cB + hstepB + kstep, voffB);
        PG8_WAIT_V(6); PG8_BAR;
    }
    for (;;) {
        const bool has_next = S.next(ui + 1, nxt);
        const char* nA = has_next ? PG8_ABASE(nxt) : cA; const char* nB = has_next ? (const char*)g.Bt + (size_t)nxt.pn * tstepB : cB;
        for (int t = 0; t < nt; t += 2) {
            const bool last = (t == nt - 2);
            const char* a1 = cA + (size_t)(t + 1) * kstep;
            const char* a2 = last ? nA : cA + (size_t)(t + 2) * kstep; const char* b2 = last ? nB : cB + (size_t)(t + 2) * kstep;
            const char* a3 = a2 + kstep; const char* b3 = b2 + kstep;
            if (last && has_next) S.a_ready(nxt);
            if constexpr (SP2) {
            PG8_LDB(B0, 0, 0); PG8_LDB(B1, 0, 1); PG8_SCHED; PG8_LDA(At, 0, 0); PG8_STAGE(PG8_SA(1, 1), a1 + hstepA, voffA);
            PG8_WAIT_V(8); PG8_WAIT_L(0); PG8_BAR; PG8_MMA(0, 0, At, B0); PG8_MMA(0, 1, At, B1); PG8_BAR; PG8_SCHED;
            PG8_LDA(At, 0, 1); PG8_STAGE(PG8_SB(0, 0), b2, voffB); PG8_STAGE(PG8_SB(0, 1), b2 + hstepB, voffB); PG8_STAGE(PG8_SA(0, 0), a2, voffA);
            PG8_WAIT_V(8); PG8_WAIT_L(0); PG8_BAR; PG8_MMA(1, 0, At, B0); PG8_MMA(1, 1, At, B1); PG8_BAR; PG8_SCHED;
            PG8_LDB(B0, 1, 0); PG8_LDB(B1, 1, 1); PG8_SCHED; PG8_LDA(At, 1, 0); PG8_STAGE(PG8_SA(0, 1), a2 + hstepA, voffA);
            PG8_WAIT_V(8); PG8_WAIT_L(0); PG8_BAR; PG8_MMA(0, 0, At, B0); PG8_MMA(0, 1, At, B1); PG8_BAR; PG8_SCHED;
            PG8_LDA(At, 1, 1); PG8_STAGE(PG8_SB(1, 0), b3, voffB); PG8_STAGE(PG8_SB(1, 1), b3 + hstepB, voffB); PG8_STAGE(PG8_SA(1, 0), a3, voffA);
            PG8_WAIT_V(8); PG8_WAIT_L(0); PG8_BAR; PG8_MMA(1, 0, At, B0); PG8_MMA(1, 1, At, B1); PG8_BAR; PG8_SCHED;
            } else {
            PG8_LDB(B0, 0, 0); PG8_SCHED; PG8_LDA(At, 0, 0); PG8_STAGE(PG8_SA(1, 1), a1 + hstepA, voffA);
            PG8_WAIT_L(8); PG8_BAR; PG8_WAIT_L(0); PG8_MMA(0, 0, At, B0); PG8_BAR; PG8_SCHED;
            PG8_LDB(B1, 0, 1); PG8_STAGE(PG8_SB(0, 0), b2, voffB);
            PG8_BAR; PG8_WAIT_L(0); PG8_MMA(0, 1, At, B1); PG8_BAR;
            PG8_LDA(At, 0, 1); PG8_STAGE(PG8_SA(0, 0), a2, voffA);
            PG8_BAR; PG8_WAIT_L(0); PG8_MMA(1, 0, At, B0); PG8_BAR; PG8_SCHED;
            PG8_STAGE(PG8_SB(0, 1), b2 + hstepB, voffB);
            PG8_WAIT_V(6); PG8_BAR; PG8_MMA(1, 1, At, B1); PG8_BAR;
            PG8_LDB(B0, 1, 0); PG8_SCHED; PG8_LDA(At, 1, 0); PG8_STAGE(PG8_SA(0, 1), a2 + hstepA, voffA);
            PG8_WAIT_L(8); PG8_BAR; PG8_WAIT_L(0); PG8_MMA(0, 0, At, B0); PG8_BAR; PG8_SCHED;
            PG8_LDB(B1, 1, 1); PG8_STAGE(PG8_SB(1, 0), b3, voffB);
            PG8_BAR; PG8_WAIT_L(0); PG8_MMA(0, 1, At, B1); PG8_BAR;
            PG8_LDA(At, 1, 1); PG8_STAGE(PG8_SA(1, 0), a3, voffA);
            PG8_BAR; PG8_WAIT_L(0); PG8_MMA(1, 0, At, B0); PG8_BAR; PG8_SCHED;
            PG8_STAGE(PG8_SB(1, 1), b3 + hstepB, voffB);
            PG8_WAIT_V(6); PG8_BAR; PG8_MMA(1, 1, At, B1); PG8_BAR;
            }
        }
        if constexpr (ALIGN_EPI) { if (wr == 0) PG8_BAR; }
        if constexpr (F8) asm volatile("s_nop 7\n\ts_nop 7\n\ts_nop 7" ::: "memory");
        if constexpr (!Epi::AFTER_DRAIN) { E(acc, cur, wr, wc, fr, fq); S.done(cur); }
        if (!has_next) break;
        if constexpr (Epi::CINIT) E.init_acc(acc, nxt, wc, fq);
        else {
#pragma unroll
        for (int a = 0; a < 2; ++a)
#pragma unroll
            for (int b = 0; b < 2; ++b)
#pragma unroll
                for (int m = 0; m < 4; ++m)
#pragma unroll
                    for (int n = 0; n < 2; ++n) acc[a][b][m][n] = (f32x4){0.f, 0.f, 0.f, 0.f};
        }
        cur = nxt; cA = nA; cB = nB; ++ui;
        if constexpr (ALIGN_EPI) { if (wr == 1) PG8_BAR; }
    }
    PG8_WAIT_V(0);
    if constexpr (!ALIGN_EPI) { if (wr == 0) PG8_BAR; }
    PG8_BAR;
#undef PG8_SA
#undef PG8_SB
#undef PG8_STAGE
#undef PG8_LDA
#undef PG8_LDB
#undef PG8_MMA
#undef PG8_WAIT_V
#undef PG8_WAIT_L
#undef PG8_BAR
#undef PG8_SCHED
#undef PG8_ABASE
}
}

#ifndef PG8_SP2
#define PG8_SP2 true
#endif
#ifndef PG8_ALIGN
#define PG8_ALIGN true
#endif

constexpr int NWAVES = 8;
constexpr int BATCH = 8, SEQ = 2048, DM = 4096, M = BATCH * SEQ, MEMLEN = 256, MMEM = BATCH * MEMLEN, DFF = 16384;
constexpr int POOLW = 3072, POOLG = 768, KVW = 6144, KVUW = 10240;

constexpr size_t MiB = 1u << 20;
constexpr size_t WS_CTL = 0, CTL_ZERO_BYTES = 1 * MiB;
constexpr size_t CTL_EVCNT = 768 * 1024;
constexpr size_t CTL_SS = 256 * 1024;
constexpr size_t WS_SS0 = 1 * MiB;
constexpr size_t WS_SSQ0 = 3 * MiB + 512 * 1024;
constexpr size_t WS_LSE = 2 * MiB;
constexpr size_t WS_EV = WS_LSE;
constexpr size_t WS_MKV = 4 * MiB;
constexpr size_t WS_MEMB = 20 * MiB;
constexpr size_t WS_WPG = 36 * MiB;
constexpr size_t WS_WAIN = 42 * MiB;
constexpr size_t WS_WMEMKV = 74 * MiB;
constexpr size_t WS_WAOUT = 106 * MiB;
constexpr size_t WS_XB8 = 900 * MiB;
constexpr size_t WS_WOUTP = 874 * MiB;
constexpr size_t WS_WKVB = 138 * MiB;
constexpr size_t WS_WBOUT = 218 * MiB;
constexpr size_t WS_W1 = 234 * MiB;
constexpr size_t WS_W2 = 490 * MiB;
constexpr size_t WS_XB = 746 * MiB;
constexpr size_t WS_X1 = 874 * MiB;
constexpr size_t WS_R = 1130 * MiB;
constexpr size_t WS_HID = WS_R;
constexpr size_t WS_U = WS_R, WS_POOLED = WS_R + 128 * MiB, WS_CAT = WS_R + 224 * MiB;
constexpr size_t WS_KVU = WS_R, WS_OG = WS_R + 320 * MiB, WS_CAT2 = WS_R + 416 * MiB;
constexpr size_t WS_END = 1642 * MiB;
constexpr int CW_TMO = 0, CW_CODE = 1, CW_BAR = 4096;

constexpr int RING_OFF = 0, RING_BYTES = 131072;
constexpr int LDSCTL_OFF = 143360, MISC_OFF = LDSCTL_OFF + 320;
constexpr int LDS_BYTES = 147456;

#define GAS __attribute__((address_space(1)))
#define LAS __attribute__((address_space(3)))
typedef unsigned short bf16;
typedef unsigned v4u __attribute__((ext_vector_type(4)));
typedef unsigned v2u __attribute__((ext_vector_type(2)));
typedef float f32x4 __attribute__((ext_vector_type(4)));
typedef short bf16x8 __attribute__((ext_vector_type(8)));
typedef short s16x4 __attribute__((ext_vector_type(4)));
typedef GAS unsigned gu32;
#define RLX_AGENT __ATOMIC_RELAXED, __HIP_MEMORY_SCOPE_AGENT
#define LDS_WAIT() asm volatile("s_waitcnt lgkmcnt(0)" ::: "memory")
#define VM_WAIT() asm volatile("s_waitcnt vmcnt(0)" ::: "memory")
__device__ __forceinline__ unsigned f2bf(float f) { unsigned u = __builtin_bit_cast(unsigned, f); return (u + 0x7fffu + ((u >> 16) & 1u)) >> 16; }
__device__ __forceinline__ unsigned pk2(float lo, float hi) { return f2bf(lo) | (f2bf(hi) << 16); }
__device__ __forceinline__ float bflo(unsigned w) { return __builtin_bit_cast(float, w << 16); }
__device__ __forceinline__ float bfhi(unsigned w) { return __builtin_bit_cast(float, w & 0xffff0000u); }

#define XB_TMO      128
#define XB_XCNT(j)  (256  + 64 * (j))
#define XB_XSUB(j)  (1280 + 64 * (j))
#define XB_XGEN(j)  (2304 + 64 * (j))
#define XB_TOP      3328
#define XB_TOPGEN   3392
#define XCD_BAR_WORDS 3456
#define XB_SPIN_CAP (1u << 22)
__device__ __forceinline__ unsigned xb_ld(unsigned* p)              { return __hip_atomic_load(p, __ATOMIC_RELAXED, __HIP_MEMORY_SCOPE_AGENT); }
__device__ __forceinline__ unsigned xb_add(unsigned* p, unsigned v) { return __hip_atomic_fetch_add(p, v, __ATOMIC_RELAXED, __HIP_MEMORY_SCOPE_AGENT); }
__device__ __forceinline__ unsigned xb_xcc_id() { return (unsigned)__builtin_amdgcn_s_getreg((3 << 11) | 20) & 0xFu; }
#define XB_SPIN(cond, bar) do { unsigned _sp = 0; while (cond) { __builtin_amdgcn_s_sleep(1); \
    if ((++_sp & 255u) == 0u) { if (xb_ld(&(bar)[XB_TMO])) break; if (_sp > XB_SPIN_CAP) { atomicAdd(&(bar)[XB_TMO], 1u); break; } } } } while (0)
struct XcdBarrier { unsigned* bar; unsigned x; volatile LAS unsigned* st; };
__device__ __forceinline__ XcdBarrier xcd_barrier_post(unsigned* bar, volatile LAS unsigned* st, bool leader  ) {
    XcdBarrier b; b.bar = bar; b.x = xb_xcc_id(); b.st = st;
    if (leader) (void)xb_add(&bar[XB_XCNT(b.x)], 1u);
    return b;
}
__device__ __forceinline__ void xcd_barrier_complete(unsigned* bar, unsigned x, unsigned& nloc, unsigned& nx) {
    const unsigned G = gridDim.x * gridDim.y * gridDim.z;
    unsigned sum, cnt, mine, sp = 0u;
    for (;;) {
        sum = 0u; cnt = 0u; mine = 0u;
#pragma unroll
        for (unsigned j = 0; j < 16; ++j) { const unsigned c = xb_ld(&bar[XB_XCNT(j)]); sum += c; cnt += (c > 0u) ? 1u : 0u; mine = (j == x) ? c : mine; }
        if (sum == G) break;
        __builtin_amdgcn_s_sleep(1);
        if ((++sp & 255u) == 0u) { if (xb_ld(&bar[XB_TMO])) break; if (sp > XB_SPIN_CAP) { atomicAdd(&bar[XB_TMO], 1u); break; } }
    }
    nloc = mine > 0u ? mine : 1u; nx = cnt > 0u ? cnt : 1u;
}
__device__ __forceinline__ void xcd_barrier(const XcdBarrier& b, bool leader  ) {
    asm volatile("s_waitcnt vmcnt(0)" ::: "memory");
    __syncthreads();
    if (leader) {
        unsigned* bar = b.bar;
        __builtin_amdgcn_s_waitcnt(0);
        unsigned nloc = b.st[0], nx = b.st[1];
        if (nloc == 0u) { xcd_barrier_complete(bar, b.x, nloc, nx); b.st[0] = nloc; b.st[1] = nx; }
        const unsigned old = xb_add(&bar[XB_XSUB(b.x)], 1u);
        const unsigned gen = old / nloc;
        if (old + 1u == (gen + 1u) * nloc) {
            __builtin_amdgcn_fence(__ATOMIC_RELEASE, "agent");
            asm volatile("s_waitcnt vmcnt(0)" ::: "memory");
            const unsigned og = xb_add(&bar[XB_TOP], 1u);
            const unsigned tg = og / nx;
            if (og + 1u == (tg + 1u) * nx) xb_add(&bar[XB_TOPGEN], 1u);
            else XB_SPIN(xb_ld(&bar[XB_TOPGEN]) == tg, bar);
            __builtin_amdgcn_fence(__ATOMIC_ACQUIRE, "agent");
            xb_add(&bar[XB_XGEN(b.x)], 1u);
            asm volatile("s_waitcnt vmcnt(0)" ::: "memory");
        } else {
            XB_SPIN(xb_ld(&bar[XB_XGEN(b.x)]) == gen, bar);
            __builtin_amdgcn_fence(__ATOMIC_ACQUIRE, "agent");
            asm volatile("s_waitcnt vmcnt(0)" ::: "memory");
        }
    }
    __syncthreads();
}

struct Frame {
    LAS unsigned char* lds;
    volatile LAS unsigned* MISC;
    gu32* ctl;
    int wave;
    int vcu, G;
};

__device__ __forceinline__ float wave_sum(float v) {
#pragma unroll
    for (int o = 1; o < 64; o <<= 1) v += __shfl_xor(v, o);
    return v;
}
template <int Q = 0>
__device__ __forceinline__ void p0_transpose_item(const float* W, int N, bf16* WT, int ldo, int row_off, const float* gk, const float* gn, LAS float* scr, int item, int lane, float qscale = pg8::I8_SW) {
    constexpr bool F8 = (Q != 0);
    const int nblk = N / 64, kb = item / nblk, nb = item % nblk, n0 = 64 * nb;
    const int lr = lane >> 4, lq = lane & 15;
    const int c = lane & 7, nn = lane >> 3;
#pragma unroll 1
    for (int h = 0; h < (F8 ? 2 : 1); ++h) {
    const int k0 = F8 ? 128 * kb + 64 * h : 64 * kb;
    const float* src = W + (size_t)(k0 + lr) * N + n0 + 4 * lq;
    f32x4 v[16];
#pragma unroll
    for (int i = 0; i < 16; ++i) v[i] = *(const GAS f32x4*)(src + (size_t)(4 * i) * N);
    float gkv[8];
#pragma unroll
    for (int e = 0; e < 8; ++e) gkv[e] = gk ? gk[k0 + 8 * c + e] : 1.0f;
#pragma unroll
    for (int i = 0; i < 16; ++i) { LAS float* d = scr + (4 * i + lr) * 65 + 4 * lq; d[0] = v[i].x; d[1] = v[i].y; d[2] = v[i].z; d[3] = v[i].w; }
    LDS_WAIT(); asm volatile("" ::: "memory");
#pragma unroll
    for (int j = 0; j < 8; ++j) { const int n = 8 * j + nn; const LAS float* s = scr + (8 * c) * 65 + n; const float gg = (gn ? gn[n0 + n] : 1.0f) * (Q == 1 ? 64.0f : (Q == 2 ? qscale : 1.0f));
        if constexpr (Q == 2) {
            *(GAS v2u*)((unsigned char*)WT + (size_t)(row_off + n0 + n) * ldo + k0 + 8 * c) = (v2u){pg8::pack_q8(s[0 * 65] * gkv[0] * gg, s[1 * 65] * gkv[1] * gg, s[2 * 65] * gkv[2] * gg, s[3 * 65] * gkv[3] * gg),
                                                                                                      pg8::pack_q8(s[4 * 65] * gkv[4] * gg, s[5 * 65] * gkv[5] * gg, s[6 * 65] * gkv[6] * gg, s[7 * 65] * gkv[7] * gg)};
        } else if constexpr (Q == 1) {
            int p0 = __builtin_amdgcn_cvt_pk_fp8_f32(s[0 * 65] * gkv[0] * gg, s[1 * 65] * gkv[1] * gg, 0, false); p0 = __builtin_amdgcn_cvt_pk_fp8_f32(s[2 * 65] * gkv[2] * gg, s[3 * 65] * gkv[3] * gg, p0, true);
            int p1 = __builtin_amdgcn_cvt_pk_fp8_f32(s[4 * 65] * gkv[4] * gg, s[5 * 65] * gkv[5] * gg, 0, false); p1 = __builtin_amdgcn_cvt_pk_fp8_f32(s[6 * 65] * gkv[6] * gg, s[7 * 65] * gkv[7] * gg, p1, true);
            *(GAS v2u*)((unsigned char*)WT + (size_t)(row_off + n0 + n) * ldo + k0 + 8 * c) = (v2u){(unsigned)p0, (unsigned)p1};
        } else {
        v4u o; o.x = pk2(s[0 * 65] * gkv[0] * gg, s[1 * 65] * gkv[1] * gg); o.y = pk2(s[2 * 65] * gkv[2] * gg, s[3 * 65] * gkv[3] * gg);
        o.z = pk2(s[4 * 65] * gkv[4] * gg, s[5 * 65] * gkv[5] * gg); o.w = pk2(s[6 * 65] * gkv[6] * gg, s[7 * 65] * gkv[7] * gg);
        *(GAS v4u*)(WT + (size_t)(row_off + n0 + n) * ldo + k0 + 8 * c) = o; } }
    LDS_WAIT(); asm volatile("" ::: "memory");
    }
}
__device__ __forceinline__ void row_to_bf16_ss(int lane, const float* xrow, bf16* orow, pg8::ssq_t* ssp) {
    const GAS f32x4* xr = (const GAS f32x4*)xrow + lane;
    GAS unsigned long long* o8 = (GAS unsigned long long*)orow + lane;
    float s = 0.f;
#pragma unroll
    for (int j = 0; j < 16; ++j) { const f32x4 v = xr[64 * j]; s += (v.x * v.x + v.y * v.y) + (v.z * v.z + v.w * v.w);
        o8[64 * j] = (unsigned long long)pk2(v.x, v.y) | ((unsigned long long)pk2(v.z, v.w) << 32); }
    s = wave_sum(s);
    if (lane == 0) *ssp = pg8::ssq_from(s);
}

struct Ptrs {
    const float *x, *mem, *a_norm, *a_w_in, *a_w_pg, *a_scale, *a_w_out, *kv_norm, *w_kv, *b_norm, *b_w_in, *b_w_out, *mem_norm, *w_mem_kv, *mlp_norm, *mlp_w1, *mlp_w2, *rel_bias, *final_norm;
};

__device__ __forceinline__ void p0_prologue(Frame& F, const Ptrs& P, unsigned char* ws) {
    const int lane = lane_id(), tid = F.wave * 64 + lane;
    LAS float* scr = (LAS float*)(F.lds + RING_OFF + F.wave * 16640);
    const int gw = F.vcu * NWAVES + F.wave, NGW = F.G * NWAVES;
    bf16* WAIN = (bf16*)(ws + WS_WAIN); bf16* WMEMKV = (bf16*)(ws + WS_WMEMKV); bf16* WPG = (bf16*)(ws + WS_WPG); bf16* WAOUT = (bf16*)(ws + WS_WAOUT);
    bf16* WKVB = (bf16*)(ws + WS_WKVB); bf16* WBOUT = (bf16*)(ws + WS_WBOUT); bf16* W1 = (bf16*)(ws + WS_W1); bf16* W2 = (bf16*)(ws + WS_W2);
    constexpr int I_SQ = (DM / 64) * (DM / 64);
    constexpr int I_MKV = (DM / 64) * (2048 / 64);
    constexpr int I_PG = (POOLG / 64) * (POOLG / 64);
    constexpr int I_W1 = (DM / 64) * (DFF / 64);
    constexpr int I_W2 = (DFF / 64) * (DM / 64);
    constexpr int I_KV = (DM / 128) * (KVW / 64);
    constexpr int I_BIN = (DM / 128) * (DM / 64);
    constexpr int I_BO = (2048 / 128) * (DM / 64);
    constexpr int I_W1Q = (DM / 128) * (DFF / 64);
    constexpr int I_W2Q = (DFF / 128) * (DM / 64);
    constexpr int NITEMS = 2 * I_SQ + I_BIN + 2 * I_MKV + I_W1 + I_W1Q + I_W2 + I_W2Q + I_KV + I_BO;
    for (int it = gw; it < NITEMS; it += NGW) {
        int r = it;
        if (r < I_W1) { p0_transpose_item(P.mlp_w1, DFF, W1, DM, 0, P.mlp_norm, nullptr, scr, r, lane); continue; } r -= I_W1;
        if (r < I_W1Q) { p0_transpose_item<2>(P.mlp_w1 + (size_t)DM * DFF, DFF, W1 + (size_t)DFF * DM, DM, 0, P.mlp_norm + DM, nullptr, scr, r, lane); continue; } r -= I_W1Q;
        if (r < I_W2) { p0_transpose_item(P.mlp_w2, DM, W2, DFF, 0, nullptr, nullptr, scr, r, lane); continue; } r -= I_W2;
        if (r < I_W2Q) { p0_transpose_item<2>(P.mlp_w2 + (size_t)DFF * DM, DM, W2 + (size_t)DM * DFF, DFF, 0, nullptr, nullptr, scr, r, lane, pg8::I8_SW2); continue; } r -= I_W2Q;
        if (r < I_KV) { p0_transpose_item<2>(P.w_kv, KVW, WKVB, DM, 0, P.kv_norm, nullptr, scr, r, lane); continue; } r -= I_KV;
        if (r < I_BIN) { p0_transpose_item<2>(P.b_w_in, DM, WKVB, DM, KVW, P.b_norm, nullptr, scr, r, lane); continue; } r -= I_BIN;
        if (r < I_SQ) { p0_transpose_item(P.a_w_in, DM, WAIN, DM, 0, P.a_norm, nullptr, scr, r, lane); continue; } r -= I_SQ;
        if (r < I_SQ) { const bool poolrows = (r / (DM / 64)) * 64 < POOLW;
            p0_transpose_item(P.a_w_out, DM, poolrows ? (bf16*)(ws + WS_WOUTP) : WAOUT, poolrows ? POOLW : DM, 0, nullptr, nullptr, scr, r, lane); continue; } r -= I_SQ;
        if (r < 2 * I_MKV) { const int l = r / I_MKV; r -= l * I_MKV; p0_transpose_item(P.w_mem_kv + (size_t)l * DM * 2048, 2048, WMEMKV, DM, l * 2048, P.mem_norm, nullptr, scr, r, lane); continue; } r -= 2 * I_MKV;
        p0_transpose_item<1>(P.b_w_out, DM, WBOUT, 2048, 0, nullptr, nullptr, scr, r, lane);
    }
    bf16* XB = (bf16*)(ws + WS_XB); bf16* MEMB = (bf16*)(ws + WS_MEMB); pg8::ssq_t* ss0 = (pg8::ssq_t*)(ws + WS_SSQ0); pg8::ssq_t* ssm = (pg8::ssq_t*)(ws + WS_SSQ0 + 131072);
    for (int m = gw; m < M + MMEM + POOLW; m += NGW) {
        if (m < M) row_to_bf16_ss(lane, P.x + (size_t)m * DM, XB + (size_t)m * DM, ss0 + m);
        else if (m < M + MMEM) { const int mm = m - M; row_to_bf16_ss(lane, P.mem + (size_t)mm * DM, MEMB + (size_t)mm * DM, ssm + mm); }
        else { const int rr = m - M - MMEM, g = rr / POOLG;
            const GAS f32x4* wr_ = (const GAS f32x4*)(P.a_w_pg + (size_t)rr * POOLG) + lane; const GAS f32x4* sc = (const GAS f32x4*)(P.a_scale + g * POOLG) + lane;
            GAS unsigned long long* o8 = (GAS unsigned long long*)(WPG + (size_t)rr * POOLG) + lane;
#pragma unroll
            for (int j = 0; j < 3; ++j) { const f32x4 v = wr_[64 * j] * sc[64 * j]; o8[64 * j] = (unsigned long long)pk2(v.x, v.y) | ((unsigned long long)pk2(v.z, v.w) << 32); } }
    }
    float* BT = (float*)(ws + WS_SS0 + 131072);
    for (int i = (int)blockIdx.x * 512 + tid; i < 24 * 129; i += F.G * 512) {
        const int gh = i / 129, delta = i % 129, g = gh >> 3, dil = g == 0 ? 1 : (g == 1 ? 4 : 16), dist = delta * dil;
        int bucket = dist;
        if (dist >= 16) { const float d32 = (float)dist; int lg = 16 + (int)(logf(d32 / 16.0f) / 4.852030263919617f * 16.0f); bucket = lg < 31 ? lg : 31; }
        BT[i] = P.rel_bias[bucket * 24 + gh];
    }
}

template <int D> struct AttnItem {
    const bf16* q; size_t qstride;
    const bf16* k; const bf16* v; size_t kstride;
    int key_lo;
    bf16* o; size_t ostride;
    unsigned char* o8;
    float* lse; int lse_stride;
    const float* bias;
};
#define ATT_WAIT0() asm volatile("s_waitcnt vmcnt(0) lgkmcnt(0)" ::: "memory")
template <int OFF> __device__ __forceinline__ s16x4 att_tr_read(unsigned vb) { s16x4 r; asm volatile("ds_read_b64_tr_b16 %0, %1 offset:%2" : "=&v"(r) : "v"(vb), "i"(OFF) : "memory"); return r; }
template <int D, int S, int DB0> __device__ __forceinline__ void att_pv4(f32x4 (&oacc)[D / 16], const unsigned (&vb)[D / 16], const bf16x8 p) {
    constexpr int HIOFF = (D == 256 && S >= 4) ? 65536 : 0, OFF0 = (32 * S) * (2 * D) - HIOFF, OFF1 = OFF0 + 16 * (2 * D);
    const s16x4 a0 = att_tr_read<OFF0>(vb[DB0 + 0] + HIOFF), a1 = att_tr_read<OFF1>(vb[DB0 + 0] + HIOFF), b0 = att_tr_read<OFF0>(vb[DB0 + 1] + HIOFF), b1 = att_tr_read<OFF1>(vb[DB0 + 1] + HIOFF);
    const s16x4 c0 = att_tr_read<OFF0>(vb[DB0 + 2] + HIOFF), c1 = att_tr_read<OFF1>(vb[DB0 + 2] + HIOFF), d0 = att_tr_read<OFF0>(vb[DB0 + 3] + HIOFF), d1 = att_tr_read<OFF1>(vb[DB0 + 3] + HIOFF);
    asm volatile("s_waitcnt lgkmcnt(0)" ::: "memory"); __builtin_amdgcn_sched_barrier(0);
    oacc[DB0 + 0] = __builtin_amdgcn_mfma_f32_16x16x32_bf16(__builtin_shufflevector(a0, a1, 0, 1, 2, 3, 4, 5, 6, 7), p, oacc[DB0 + 0], 0, 0, 0);
    oacc[DB0 + 1] = __builtin_amdgcn_mfma_f32_16x16x32_bf16(__builtin_shufflevector(b0, b1, 0, 1, 2, 3, 4, 5, 6, 7), p, oacc[DB0 + 1], 0, 0, 0);
    oacc[DB0 + 2] = __builtin_amdgcn_mfma_f32_16x16x32_bf16(__builtin_shufflevector(c0, c1, 0, 1, 2, 3, 4, 5, 6, 7), p, oacc[DB0 + 2], 0, 0, 0);
    oacc[DB0 + 3] = __builtin_amdgcn_mfma_f32_16x16x32_bf16(__builtin_shufflevector(d0, d1, 0, 1, 2, 3, 4, 5, 6, 7), p, oacc[DB0 + 3], 0, 0, 0);
}
template <int D, int S> __device__ __forceinline__ void att_pv_step(f32x4 (&oacc)[D / 16], const unsigned (&vb)[D / 16], const bf16x8 p) {
    att_pv4<D, S, 0>(oacc, vb, p); att_pv4<D, S, 4>(oacc, vb, p);
    if constexpr (D == 256) { att_pv4<D, S, 8>(oacc, vb, p); att_pv4<D, S, 12>(oacc, vb, p); }
}
#define ATT_BAR() do { asm volatile("" ::: "memory"); __builtin_amdgcn_s_barrier(); asm volatile("" ::: "memory"); } while (0)
template <int D, bool DIL, class Maker>
__device__ __forceinline__ void attn_run(LAS unsigned char* lds, const Maker& mk, int first, int stride, int nitems, const int w  ) {
    const int lane = lane_id(), tid = w * 64 + lane;
    constexpr int NDC = D / 64, NKB = 2 * NDC, NV = D / 16, CPR = D / 8, RPB = 64 / CPR;
    constexpr int KOFF = 0, VOFF = (D == 128) ? 65536 : 0, BTOFF = 131072;
    if (first >= nitems) return;
    const int g = lane >> 4, c = lane & 15;
    LAS float* bt = (LAS float*)(lds + BTOFF);
    int Rk[2], Ck[2];
#pragma unroll
    for (int i = 0; i < 2; ++i) pg8::stage_rc(tid * 16 + i * 8192, Rk[i], Ck[i]);
    const int vrow = lane / CPR, vpos = lane % CPR;
    const int q4 = c >> 2, p4 = c & 3, sw3 = 4 * (g & 1) + q4;
    const unsigned vlane = VOFF + (4 * g + q4) * (2 * D) + 8 * (p4 & 1) + 16 * (p4 >> 1);
    const unsigned klane = KOFF + pg8::lds_byte(c, 8 * g);
    const unsigned ldsbase = (unsigned)(size_t)lds;
    bf16x8 qf[D / 32];
    f32x4 sacc[16];
    f32x4 oacc[D / 16];
    bf16x8 pf[8];
    float rl = 1.f, rm = 0.f;
#define ATT_ISSUE_K(it) do { int wv = w; asm volatile("" : "+s"(wv)); _Pragma("unroll") for (int hb = 0; hb < NKB; ++hb) { _Pragma("unroll") for (int i = 0; i < 2; ++i) { int row = (hb / NDC) * 128 + Rk[i]; row = row < (it).key_lo ? (it).key_lo : row; \
        __builtin_amdgcn_global_load_lds((const unsigned*)((it).k + (size_t)row * (it).kstride + (hb % NDC) * 64 + Ck[i]), (LAS unsigned*)(lds + KOFF + hb * 16384 + i * 8192 + wv * 1024), 16, 0, 0); } } } while (0)
#define ATT_ISSUE_V(it) do { int wv = w; asm volatile("" : "+s"(wv)); _Pragma("unroll") for (int j = 0; j < NV; ++j) { const int row = (j * 8 + wv) * RPB + vrow; const int rowc = row < (it).key_lo ? (it).key_lo : row; const int ch = vpos ^ ((row & 7) << 1); \
        __builtin_amdgcn_global_load_lds((const unsigned*)((it).v + (size_t)rowc * (it).kstride + 8 * ch), (LAS unsigned*)(lds + VOFF + (j * 8 + wv) * 1024), 16, 0, 0); } } while (0)
#define ATT_LOAD_Q(it) do { const bf16* qp = (it).q + (size_t)(16 * w + c) * (it).qstride + 8 * g; _Pragma("unroll") for (int s = 0; s < D / 32; ++s) qf[s] = *(const GAS bf16x8*)(qp + 32 * s); } while (0)
#define ATT_S_SOFTMAX(it) do { int wv = w; asm volatile("" : "+s"(wv)); \
    const int kb_lo = DIL ? (wv > ((it).key_lo >> 4) ? wv : ((it).key_lo >> 4)) : 0, kb_hi = DIL ? wv + 8 : 15; \
    _Pragma("unroll") for (int kb = 0; kb < 16; ++kb) sacc[kb] = (f32x4){0.f, 0.f, 0.f, 0.f}; \
    _Pragma("unroll") for (int kb = 0; kb < 16; ++kb) { if (kb >= kb_lo && kb <= kb_hi) { \
        _Pragma("unroll") for (int s = 0; s < D / 32; ++s) { \
            const bf16x8 kf = *(const LAS bf16x8*)(lds + klane + ((kb >> 3) * NDC + (s >> 1)) * 16384 + ((kb & 7) * 2 + (s & 1)) * 1024); \
            sacc[kb] = __builtin_amdgcn_mfma_f32_16x16x32_bf16(kf, qf[s], sacc[kb], 0, 0, 0); } } } \
    const float scale = DIL ? 0.08838834764831845f : 0.0625f; int ql = 16 * wv + c; asm volatile("" : "+v"(ql)); float mx = -3.0e38f; \
    _Pragma("unroll") for (int kb = 0; kb < 16; ++kb) { _Pragma("unroll") for (int r = 0; r < 4; ++r) { float lg; \
        if (DIL) { const int kl = 16 * kb + 4 * g + r, delta = ql + 128 - kl; const bool ok = (kb >= kb_lo) && (kb <= kb_hi) && delta >= 0 && delta <= 128 && kl >= (it).key_lo; \
            const int di = delta < 0 ? 0 : (delta > 128 ? 128 : delta); lg = ok ? sacc[kb][r] * scale + bt[di] : -3.0e38f; } \
        else lg = sacc[kb][r] * scale; \
        sacc[kb][r] = lg; mx = fmaxf(mx, lg); } } \
    mx = fmaxf(mx, __shfl_xor(mx, 16)); mx = fmaxf(mx, __shfl_xor(mx, 32)); float sum = 0.f; \
    _Pragma("unroll") for (int kb = 0; kb < 16; ++kb) { _Pragma("unroll") for (int r = 0; r < 4; ++r) { const float lg = sacc[kb][r]; const float p = lg > -1.0e38f ? __expf(lg - mx) : 0.f; sacc[kb][r] = p; sum += p; } } \
    sum += __shfl_xor(sum, 16); sum += __shfl_xor(sum, 32); rl = sum; rm = mx; \
    _Pragma("unroll") for (int s = 0; s < 8; ++s) { v4u pw; pw.x = pk2(sacc[2 * s][0], sacc[2 * s][1]); pw.y = pk2(sacc[2 * s][2], sacc[2 * s][3]); pw.z = pk2(sacc[2 * s + 1][0], sacc[2 * s + 1][1]); pw.w = pk2(sacc[2 * s + 1][2], sacc[2 * s + 1][3]); \
        pf[s] = __builtin_bit_cast(bf16x8, pw); } } while (0)
#define ATT_PV_STORE(it) do { int wv = w; asm volatile("" : "+s"(wv)); \
    const int kb_lo = DIL ? (wv > ((it).key_lo >> 4) ? wv : ((it).key_lo >> 4)) : 0, kb_hi = DIL ? wv + 8 : 15; \
    _Pragma("unroll") for (int i = 0; i < D / 16; ++i) oacc[i] = (f32x4){0.f, 0.f, 0.f, 0.f}; \
    unsigned vb[D / 16]; _Pragma("unroll") for (int db = 0; db < D / 16; ++db) vb[db] = ldsbase + vlane + 32 * (db ^ sw3); \
    if (1 >= kb_lo && 0 <= kb_hi) att_pv_step<D, 0>(oacc, vb, pf[0]); \
    if (3 >= kb_lo && 2 <= kb_hi) att_pv_step<D, 1>(oacc, vb, pf[1]); \
    if (5 >= kb_lo && 4 <= kb_hi) att_pv_step<D, 2>(oacc, vb, pf[2]); \
    if (7 >= kb_lo && 6 <= kb_hi) att_pv_step<D, 3>(oacc, vb, pf[3]); \
    if (9 >= kb_lo && 8 <= kb_hi) att_pv_step<D, 4>(oacc, vb, pf[4]); \
    if (11 >= kb_lo && 10 <= kb_hi) att_pv_step<D, 5>(oacc, vb, pf[5]); \
    if (13 >= kb_lo && 12 <= kb_hi) att_pv_step<D, 6>(oacc, vb, pf[6]); \
    if (15 >= kb_lo && 14 <= kb_hi) att_pv_step<D, 7>(oacc, vb, pf[7]); \
    const float inv = 1.0f / rl; bf16* op = (it).o + (size_t)(16 * w + c) * (it).ostride + 4 * g; \
    if ((it).o8) { const float inv16 = inv * 16.0f; unsigned char* op8 = (it).o8 + (size_t)(16 * w + c) * (it).ostride + 4 * g; \
        _Pragma("unroll") for (int db = 0; db < D / 16; ++db) { int p = __builtin_amdgcn_cvt_pk_fp8_f32(oacc[db][0] * inv16, oacc[db][1] * inv16, 0, false); p = __builtin_amdgcn_cvt_pk_fp8_f32(oacc[db][2] * inv16, oacc[db][3] * inv16, p, true); *(GAS int*)(op8 + 16 * db) = p; } } \
    else { _Pragma("unroll") for (int db = 0; db < D / 16; ++db) { v2u o2; o2.x = pk2(oacc[db][0] * inv, oacc[db][1] * inv); o2.y = pk2(oacc[db][2] * inv, oacc[db][3] * inv); *(GAS v2u*)(op + 16 * db) = o2; } } \
    if (DIL) { if (g == 0) (it).lse[(size_t)(16 * w + c) * (it).lse_stride] = rm + __logf(rl); } } while (0)

#define ATT_QFENCE() do { _Pragma("unroll") for (int s = 0; s < D / 32; ++s) asm volatile("" :: "v"(qf[s])); } while (0)
#define ATT_ITEM(idv) ([&]() { int _i = (idv); asm volatile("" : "+s"(_i)); return mk(_i); }())
    if constexpr (D == 128) {
        int id = first;
        { const AttnItem<D> it = ATT_ITEM(id); ATT_ISSUE_K(it); ATT_LOAD_Q(it); }
        for (;;) {
            { const AttnItem<D> it = ATT_ITEM(id);
              if (DIL) { if (tid < 129) bt[tid] = it.bias[tid]; }
              ATT_WAIT0(); ATT_QFENCE(); ATT_BAR();
              ATT_ISSUE_V(it); }
            { const AttnItem<D> it = ATT_ITEM(id); ATT_S_SOFTMAX(it); }
            ATT_WAIT0(); ATT_BAR();
            const int nid = id + stride; const bool has_next = nid < nitems;
            if (has_next) { const AttnItem<D> it = ATT_ITEM(nid); ATT_ISSUE_K(it); ATT_LOAD_Q(it); }
            { const AttnItem<D> it = ATT_ITEM(id); ATT_PV_STORE(it); }
            if (!has_next) break;
            id = nid;
        }
    } else {
        for (int id = first; id < nitems; id += stride) {
            { const AttnItem<D> it = ATT_ITEM(id); ATT_ISSUE_K(it); ATT_LOAD_Q(it); }
            ATT_WAIT0(); ATT_QFENCE(); ATT_BAR();
            { const AttnItem<D> it = ATT_ITEM(id); ATT_S_SOFTMAX(it); }
            ATT_WAIT0(); ATT_BAR();
            { const AttnItem<D> it = ATT_ITEM(id); ATT_ISSUE_V(it); }
            ATT_WAIT0(); ATT_BAR();
            { const AttnItem<D> it = ATT_ITEM(id); ATT_PV_STORE(it); }
            ATT_WAIT0(); ATT_BAR();
        }
    }
#undef ATT_ITEM
#undef ATT_QFENCE
    ATT_WAIT0(); ATT_BAR();
#undef ATT_ISSUE_K
#undef ATT_ISSUE_V
#undef ATT_LOAD_Q
#undef ATT_S_SOFTMAX
#undef ATT_PV_STORE
}

__device__ __forceinline__ void pool_phase(Frame& F, const bf16* U, bf16* POOLED) {
    const int lane = lane_id();
    const int gw = F.vcu * NWAVES + F.wave, NGW = F.G * NWAVES;
    constexpr int NTC = SEQ / 64, NCC = POOLW / 512, NIT = BATCH * NTC * NCC;
    for (int itx = gw; itx < NIT; itx += NGW) {
        const int cc = itx % NCC, tc = (itx / NCC) % NTC, b = itx / (NCC * NTC);
        const int col = 512 * cc + 8 * lane, w = 2 << (col / POOLG);
        const int t0 = 64 * tc, ts = t0 >= 16 ? t0 - 16 : 0;
        const bf16* ub = U + (size_t)b * SEQ * DM + col;
        bf16* pb = POOLED + (size_t)b * SEQ * DM + col;
        float S[8];
#pragma unroll
        for (int j = 0; j < 8; ++j) S[j] = 0.f;
#pragma unroll 8
        for (int t = ts; t < t0 + 64; ++t) {
            const v4u cur = *(const GAS v4u*)(ub + (size_t)t * DM);
            const int to = (t - w >= ts) ? t - w : t; const float sg = (t - w >= ts) ? 1.f : 0.f;
            const v4u old = *(const GAS v4u*)(ub + (size_t)to * DM);
            float cv[8] = {bflo(cur.x), bfhi(cur.x), bflo(cur.y), bfhi(cur.y), bflo(cur.z), bfhi(cur.z), bflo(cur.w), bfhi(cur.w)};
            float ov[8] = {bflo(old.x), bfhi(old.x), bflo(old.y), bfhi(old.y), bflo(old.z), bfhi(old.z), bflo(old.w), bfhi(old.w)};
#pragma unroll
            for (int j = 0; j < 8; ++j) S[j] += cv[j] - sg * ov[j];
            if (t >= t0) { const float ic = 1.0f / (float)((t + 1) < w ? (t + 1) : w); v4u o;
                o.x = pk2(S[0] * ic - cv[0], S[1] * ic - cv[1]); o.y = pk2(S[2] * ic - cv[2], S[3] * ic - cv[3]); o.z = pk2(S[4] * ic - cv[4], S[5] * ic - cv[5]); o.w = pk2(S[6] * ic - cv[6], S[7] * ic - cv[7]);
                *(GAS v4u*)(pb + (size_t)t * DM) = o; }
        }
    }
}
__device__ __forceinline__ void merge_phase(Frame& F, const bf16* OG, const float* LSE, unsigned char* CAT2) {
    const int gw = F.vcu * NWAVES + F.wave, NGW = F.G * NWAVES;
    const int lane = lane_id(), h = lane >> 3, col = h * 128 + 16 * (lane & 7);
    for (int row = gw; row < M; row += NGW) {
        const float* lp = LSE + (size_t)row * 24 + h * 3;
        const float l0 = lp[0], l1 = lp[1], l2 = lp[2];
        const float mx = fmaxf(l0, fmaxf(l1, l2));
        float w0 = __expf(l0 - mx), w1 = __expf(l1 - mx), w2 = __expf(l2 - mx); const float inv = 1.0f / (w0 + w1 + w2); w0 *= inv; w1 *= inv; w2 *= inv;
        float acc[16];
#pragma unroll
        for (int j = 0; j < 16; ++j) acc[j] = 0.f;
#pragma unroll
        for (int g = 0; g < 3; ++g) { const float wg = g == 0 ? w0 : (g == 1 ? w1 : w2); const bf16* src = OG + (size_t)g * M * 1024 + (size_t)row * 1024 + col;
#pragma unroll
            for (int hh = 0; hh < 2; ++hh) { const v4u x = *(const GAS v4u*)(src + 8 * hh);
                acc[8 * hh + 0] += wg * bflo(x.x); acc[8 * hh + 1] += wg * bfhi(x.x); acc[8 * hh + 2] += wg * bflo(x.y); acc[8 * hh + 3] += wg * bfhi(x.y);
                acc[8 * hh + 4] += wg * bflo(x.z); acc[8 * hh + 5] += wg * bfhi(x.z); acc[8 * hh + 6] += wg * bflo(x.w); acc[8 * hh + 7] += wg * bfhi(x.w); } }
        v4u o;
        { int p = __builtin_amdgcn_cvt_pk_fp8_f32(acc[0] * 16.f, acc[1] * 16.f, 0, false); p = __builtin_amdgcn_cvt_pk_fp8_f32(acc[2] * 16.f, acc[3] * 16.f, p, true); o.x = (unsigned)p; }
        { int p = __builtin_amdgcn_cvt_pk_fp8_f32(acc[4] * 16.f, acc[5] * 16.f, 0, false); p = __builtin_amdgcn_cvt_pk_fp8_f32(acc[6] * 16.f, acc[7] * 16.f, p, true); o.y = (unsigned)p; }
        { int p = __builtin_amdgcn_cvt_pk_fp8_f32(acc[8] * 16.f, acc[9] * 16.f, 0, false); p = __builtin_amdgcn_cvt_pk_fp8_f32(acc[10] * 16.f, acc[11] * 16.f, p, true); o.z = (unsigned)p; }
        { int p = __builtin_amdgcn_cvt_pk_fp8_f32(acc[12] * 16.f, acc[13] * 16.f, 0, false); p = __builtin_amdgcn_cvt_pk_fp8_f32(acc[14] * 16.f, acc[15] * 16.f, p, true); o.w = (unsigned)p; }
        *(GAS v4u*)(CAT2 + (size_t)row * 2048 + col) = o;
    }
}
__device__ __forceinline__ void w2q_colsum_phase(Frame& F, const unsigned char* W2Q, int* CS) {
    const int gw = F.vcu * NWAVES + F.wave, NGW = F.G * NWAVES, lane = lane_id();
    for (int n = gw; n < DM; n += NGW) {
        const GAS v4u* p = (const GAS v4u*)(W2Q + (size_t)n * DFF) + lane;
        v4u x[16];
#pragma unroll
        for (int j = 0; j < 16; ++j) x[j] = p[64 * j];
        int s = 0;
#define W2Q_BSUM(u) { const int w = (int)(u); s += ((w << 24) >> 24) + ((w << 16) >> 24) + ((w << 8) >> 24) + (w >> 24); }
#pragma unroll
        for (int j = 0; j < 16; ++j) { W2Q_BSUM(x[j].x) W2Q_BSUM(x[j].y) W2Q_BSUM(x[j].z) W2Q_BSUM(x[j].w) }
#undef W2Q_BSUM
#pragma unroll
        for (int o = 1; o < 64; o <<= 1) s += __shfl_xor(s, o);
        if (lane == 0) CS[n] = 128 * s;
    }
}
__device__ __forceinline__ void final_norm_phase(Frame& F, const bf16* XB, float* out, const float* gain, const int* evcnt, const int* ev, const float* W2f) {
    const int gw = F.vcu * NWAVES + F.wave, NGW = F.G * NWAVES, lane = lane_id();
    for (int row = gw; row < M; row += NGW) {
        const GAS v4u* xr = (const GAS v4u*)(XB + (size_t)row * DM) + lane; GAS f32x4* orow = (GAS f32x4*)(out + (size_t)row * DM) + 2 * lane; const GAS f32x4* gr = (const GAS f32x4*)gain + 2 * lane;
        v4u x[8];
#pragma unroll
        for (int j = 0; j < 8; ++j) x[j] = xr[64 * j];
        int cnt = __builtin_amdgcn_readfirstlane(evcnt[row]); cnt = cnt < pg8::EV_MAX ? cnt : pg8::EV_MAX;
        f32x4 o0[8], o1[8];
#pragma unroll
        for (int j = 0; j < 8; ++j) { o0[j] = (f32x4){bflo(x[j].x), bfhi(x[j].x), bflo(x[j].y), bfhi(x[j].y)}; o1[j] = (f32x4){bflo(x[j].z), bfhi(x[j].z), bflo(x[j].w), bfhi(x[j].w)}; }
        if (cnt > 0) {
            const int ek = lane < cnt ? ev[((size_t)row * pg8::EV_MAX + lane) * 2] : 0x7fffffff; const float ee = lane < cnt ? __builtin_bit_cast(float, ev[((size_t)row * pg8::EV_MAX + lane) * 2 + 1]) : 0.f;
            int rank = 0;
#pragma unroll
            for (int j = 0; j < pg8::EV_MAX; ++j) rank += (__shfl(ek, j) < ek) ? 1 : 0;
            for (int a = 0; a < cnt; ++a) {
                const unsigned long long mask = __ballot(lane < cnt && rank == a); const int src = __builtin_ctzll(mask);
                const int k = __shfl(ek, src); const float e = __shfl(ee, src);
                const GAS f32x4* wr = (const GAS f32x4*)(W2f + (size_t)k * DM) + 2 * lane;
#pragma unroll
                for (int j = 0; j < 8; ++j) { const f32x4 w0 = wr[128 * j], w1 = wr[128 * j + 1]; o0[j] += w0 * e; o1[j] += w1 * e; }
            }
        }
        float s = 0.f;
#pragma unroll
        for (int j = 0; j < 8; ++j) s += (o0[j].x * o0[j].x + o0[j].y * o0[j].y) + (o0[j].z * o0[j].z + o0[j].w * o0[j].w) + (o1[j].x * o1[j].x + o1[j].y * o1[j].y) + (o1[j].z * o1[j].z + o1[j].w * o1[j].w);
        s = wave_sum(s);
        const float r = __builtin_amdgcn_rsqf(s * (1.0f / 4096.0f) + pg8::RMS_EPS);
#pragma unroll
        for (int j = 0; j < 8; ++j) { const f32x4 g0 = gr[128 * j], g1 = gr[128 * j + 1]; orow[128 * j] = o0[j] * r * g0; orow[128 * j + 1] = o1[j] * r * g1; }
    }
}

struct MemMaker { const bf16* Qsrc; int ldq, qcol0; const bf16* MKV; int l; bf16* Odst; int ldo, ocol0; unsigned char* Odst8;
    __device__ __forceinline__ AttnItem<256> operator()(int id) const {
        const int qt = id % (SEQ / 128), h = (id / (SEQ / 128)) % 4, b = id / (4 * (SEQ / 128));
        AttnItem<256> it;
        it.q = Qsrc + (size_t)(b * SEQ + 128 * qt) * ldq + qcol0 + h * 256; it.qstride = (size_t)ldq;
        it.k = MKV + (size_t)(b * MEMLEN) * DM + l * 2048 + h * 256; it.v = it.k + 1024; it.kstride = DM; it.key_lo = 0;
        it.o = Odst + (size_t)(b * SEQ + 128 * qt) * ldo + ocol0 + h * 256; it.ostride = (size_t)ldo; it.lse = nullptr; it.lse_stride = 0; it.bias = nullptr;
        it.o8 = Odst8 ? Odst8 + (size_t)(b * SEQ + 128 * qt) * ldo + ocol0 + h * 256 : nullptr;
        return it; } };
__device__ __forceinline__ void memattn_phase(Frame& F, const bf16* Qsrc, int ldq, int qcol0, const bf16* MKV, int l, bf16* Odst, int ldo, int ocol0, unsigned char* Odst8) {
    const MemMaker mk{Qsrc, ldq, qcol0, MKV, l, Odst, ldo, ocol0, Odst8};
    attn_run<256, false>(F.lds + RING_OFF, mk, F.vcu, F.G, BATCH * 4 * (SEQ / 128), F.wave);
}
struct DilMaker { const bf16* KVU; bf16* OG; float* LSE; const float* BT;
    __device__ __forceinline__ AttnItem<128> operator()(int id) const {
        const int j = id & 15, g = (id >> 4) % 3, h = ((id >> 4) / 3) & 7, b = (id >> 4) / 24;
        const int dil = g == 0 ? 1 : (g == 1 ? 4 : 16), r = g == 0 ? 0 : (g == 1 ? (j >> 2) : j), n = g == 0 ? j : (g == 1 ? (j & 3) : 0);
        AttnItem<128> it;
        const size_t rs = (size_t)dil * KVUW;
        const long row_q0 = (long)b * SEQ + (long)(128 * n) * dil + r;
        it.q = KVU + (size_t)row_q0 * KVUW + KVW + g * 1024 + h * 128; it.qstride = rs;
        const bf16* kq0 = KVU + (size_t)row_q0 * KVUW + g * 1024 + h * 128;
        it.k = kq0 - 128 * rs; it.v = it.k + 3072; it.kstride = rs; it.key_lo = n == 0 ? 128 : 0;
        it.o = OG + (size_t)g * M * 1024 + (size_t)row_q0 * 1024 + h * 128; it.ostride = (size_t)dil * 1024; it.o8 = nullptr;
        it.lse = LSE + (size_t)row_q0 * 24 + h * 3 + g; it.lse_stride = dil * 24; it.bias = BT + (g * 8 + h) * 129;
        return it; } };
__device__ __forceinline__ void dilattn_phase(Frame& F, const bf16* KVU, bf16* OG, float* LSE, const float* BT) {
    const DilMaker mk{KVU, OG, LSE, BT};
    attn_run<128, true>(F.lds + RING_OFF, mk, F.vcu, F.G, BATCH * 8 * 3 * 16, F.wave);
}

struct Args { const float* in[19]; float* out; unsigned char* ws; int ph_lo, ph_hi, li, pad; };
constexpr int N_STEPS = 14;
typedef const Args __attribute__((address_space(4))) CArgs;
__device__ __forceinline__ CArgs* kargs() { CArgs* p = (CArgs*)__builtin_amdgcn_kernarg_segment_ptr(); asm volatile("" : "+s"(p)); return p; }
#ifndef MK_ONLY
#define MK_ONLY -1
#endif
#define STEP_ON(k) (MK_ONLY < 0 || MK_ONLY == (k))

template <int L> __device__ __forceinline__ void step_inproj(Frame& F) {
    CArgs* ap = kargs(); unsigned char* ws = ap->ws;
    if constexpr (L == 0) {
        pg8::Gemm g; g.A = (const bf16*)(ws + WS_XB); g.Bt = (const bf16*)(ws + WS_WAIN); g.M = M; g.N = DM; g.K = DM; g.lda = DM; g.ldb = DM; g.npg = 0; g.a_gstride = 0;
        pg8::StaticOrder S; S.init(g.M, g.N, F.G, (int)blockIdx.x);
        pg8::EpiScaleBf16<0> E{nullptr, nullptr, (bf16*)(ws + WS_U), DM, (const pg8::ssq_t*)(ws + WS_SSQ0), 1.0f};
        pg8::gemm_phase<pg8::EpiScaleBf16<0>, pg8::StaticOrder, PG8_ALIGN, PG8_SP2>(F.lds + RING_OFF, g, S, E, F.wave);
    } else {
        pg8::Gemm g; g.A = (const bf16*)(ws + WS_XB8); g.Bt = (const bf16*)(ws + WS_WKVB); g.M = M; g.N = KVUW; g.K = DM / 2; g.lda = DM / 2; g.ldb = DM / 2; g.npg = 0; g.a_gstride = 0;
        pg8::StaticOrder S; S.init(g.M, g.N, F.G, (int)blockIdx.x);
        pg8::EpiScaleBf16<0, true> E{nullptr, nullptr, (bf16*)(ws + WS_KVU), KVUW, (const pg8::ssq_t*)(ws + WS_CTL + CTL_SS) + 1 * M, pg8::X2_RMS_RATIO / (pg8::I8_SA * pg8::I8_SW), (const pg8::ssq_t*)(ws + WS_CTL + CTL_SS) + 0 * M};
        pg8::gemm_phase<pg8::EpiScaleBf16<0, true>, pg8::StaticOrder, PG8_ALIGN, PG8_SP2, false, true>(F.lds + RING_OFF, g, S, E, F.wave);
    }
    const int Gh = F.G / 2;
    if (L == 0 && (int)blockIdx.x < Gh) {
        pg8::Gemm g; g.A = (const bf16*)(ws + WS_MEMB); g.Bt = (const bf16*)(ws + WS_WMEMKV); g.M = MMEM; g.N = DM; g.K = DM; g.lda = DM; g.ldb = DM; g.npg = 0; g.a_gstride = 0;
        pg8::StaticOrder S; S.init(g.M, g.N, Gh, (int)blockIdx.x);
        pg8::EpiScaleBf16<0> E{nullptr, nullptr, (bf16*)(ws + WS_MKV), DM, (const pg8::ssq_t*)(ws + WS_SSQ0 + 131072), 1.0f};
        pg8::gemm_phase<pg8::EpiScaleBf16<0>, pg8::StaticOrder, PG8_ALIGN, PG8_SP2>(F.lds + RING_OFF, g, S, E, F.wave);
    }
    if (L == 0 && (int)blockIdx.x >= Gh) {
        pg8::Gemm g; g.A = (const bf16*)(ws + WS_WOUTP); g.Bt = (const bf16*)(ws + WS_WPG); g.M = DM; g.N = POOLW; g.K = POOLG; g.lda = POOLW; g.ldb = POOLG; g.npg = 3; g.a_gstride = POOLG * 2;
        pg8::StaticOrder S; S.init(g.M, g.N, F.G - Gh, (int)blockIdx.x - Gh);
        pg8::EpiScaleBf16<0> E{nullptr, nullptr, (bf16*)(ws + WS_WAOUT), DM, nullptr, 1.0f};
        pg8::gemm_phase<pg8::EpiScaleBf16<0>, pg8::StaticOrder, PG8_ALIGN, PG8_SP2>(F.lds + RING_OFF, g, S, E, F.wave);
    }
}
template <int L> __device__ __forceinline__ void step_mixer(Frame& F) {
    CArgs* ap = kargs(); unsigned char* ws = ap->ws;
    if (L == 0) {
        pool_phase(F, (const bf16*)(ws + WS_U), (bf16*)(ws + WS_CAT));
        memattn_phase(F, (const bf16*)(ws + WS_U), DM, POOLW, (const bf16*)(ws + WS_MKV), 0, (bf16*)(ws + WS_CAT), DM, POOLW, nullptr);
    } else {
        dilattn_phase(F, (const bf16*)(ws + WS_KVU), (bf16*)(ws + WS_OG), (float*)(ws + WS_LSE), (const float*)(ws + WS_SS0 + 131072));
        memattn_phase(F, (const bf16*)(ws + WS_KVU), KVUW, KVW + 3072, (const bf16*)(ws + WS_MKV), 1, nullptr, 2048, 1024, ws + WS_CAT2);
    }
}
template <int L> __device__ __forceinline__ void step_mix2(Frame& F) {
    CArgs* ap = kargs(); unsigned char* ws = ap->ws;
    if (L == 0) {
    } else {
        w2q_colsum_phase(F, ws + WS_W2 + (size_t)DM * DFF * 2, (int*)(ws + WS_SS0));
        merge_phase(F, (const bf16*)(ws + WS_OG), (const float*)(ws + WS_LSE), ws + WS_CAT2);
    }
}
template <int L> __device__ __forceinline__ void step_outproj(Frame& F) {
    CArgs* ap = kargs(); unsigned char* ws = ap->ws;
    pg8::StaticOrder S; S.init(M, DM, F.G, (int)blockIdx.x);
    if constexpr (L == 0) {
        pg8::Gemm g; g.A = (const bf16*)(ws + WS_CAT); g.Bt = (const bf16*)(ws + WS_WAOUT); g.M = M; g.N = DM; g.K = DM; g.lda = DM; g.ldb = DM; g.npg = 0; g.a_gstride = 0;
        pg8::EpiResid<0> E{(const bf16*)(ws + WS_XB), (bf16*)(ws + WS_XB), (pg8::ssq_t*)(ws + WS_CTL + CTL_SS) + 0 * M, nullptr, 1.0f, nullptr, 0.f, nullptr};
        pg8::gemm_phase<pg8::EpiResid<0>, pg8::StaticOrder, PG8_ALIGN, PG8_SP2>(F.lds + RING_OFF, g, S, E, F.wave);
    } else {
        pg8::Gemm g; g.A = (const bf16*)(ws + WS_CAT2); g.Bt = (const bf16*)(ws + WS_WBOUT); g.M = M; g.N = DM; g.K = 1024; g.lda = 1024; g.ldb = 1024; g.npg = 0; g.a_gstride = 0;
        pg8::EpiResid<2> E{(const bf16*)(ws + WS_XB), (bf16*)(ws + WS_XB), (pg8::ssq_t*)(ws + WS_CTL + CTL_SS) + 2 * M, ws + WS_XB8, 1.0f / 1024.0f, (const pg8::ssq_t*)(ws + WS_CTL + CTL_SS) + 1 * M, pg8::I8_SA, nullptr};
        pg8::gemm_phase<pg8::EpiResid<2>, pg8::StaticOrder, PG8_ALIGN, PG8_SP2, true>(F.lds + RING_OFF, g, S, E, F.wave);
    }
}
template <int L> __device__ __forceinline__ void step_mlp1(Frame& F) {
    CArgs* ap = kargs(); unsigned char* ws = ap->ws;
    if constexpr (L == 0) {
    pg8::Gemm g; g.A = (const bf16*)(ws + WS_XB); g.Bt = (const bf16*)(ws + WS_W1); g.M = M; g.N = DFF; g.K = DM; g.lda = DM; g.ldb = DM; g.npg = 0; g.a_gstride = 0;
    pg8::StaticOrder S; S.init(g.M, g.N, F.G, (int)blockIdx.x);
    pg8::EpiScaleBf16<1> E{nullptr, nullptr, (bf16*)(ws + WS_HID), DFF, (const pg8::ssq_t*)(ws + WS_CTL + CTL_SS) + 0 * M, 1.0f, nullptr};
    pg8::gemm_phase<pg8::EpiScaleBf16<1>, pg8::StaticOrder, PG8_ALIGN, PG8_SP2>(F.lds + RING_OFF, g, S, E, F.wave);
    } else {
    pg8::Gemm g; g.A = (const bf16*)(ws + WS_XB8); g.Bt = (const bf16*)(ws + WS_W1) + (size_t)DFF * DM; g.M = M; g.N = DFF; g.K = DM / 2; g.lda = DM / 2; g.ldb = DM / 2; g.npg = 0; g.a_gstride = 0;
    pg8::StaticOrder S; S.init(g.M, g.N, F.G, (int)blockIdx.x);
    pg8::EpiScaleBf16<1, true, 1> E{(int*)(ws + WS_CTL + CTL_EVCNT), (int*)(ws + WS_EV), (bf16*)(ws + WS_HID), DFF, (const pg8::ssq_t*)(ws + WS_CTL + CTL_SS) + 2 * M, 1.0f / (pg8::I8_SA * pg8::I8_SW), (const pg8::ssq_t*)(ws + WS_CTL + CTL_SS) + 1 * M};
    pg8::gemm_phase<pg8::EpiScaleBf16<1, true, 1>, pg8::StaticOrder, PG8_ALIGN, PG8_SP2, false, true>(F.lds + RING_OFF, g, S, E, F.wave);
    }
}
template <int L> __device__ __forceinline__ void step_mlp2(Frame& F) {
    CArgs* ap = kargs(); unsigned char* ws = ap->ws;
    if constexpr (L == 0) {
    pg8::Gemm g; g.A = (const bf16*)(ws + WS_HID); g.Bt = (const bf16*)(ws + WS_W2); g.M = M; g.N = DM; g.K = DFF; g.lda = DFF; g.ldb = DFF; g.npg = 0; g.a_gstride = 0;
    pg8::StaticOrder S; S.init(g.M, g.N, F.G, (int)blockIdx.x);
    pg8::EpiResid<2> E{(const bf16*)(ws + WS_XB), (bf16*)(ws + WS_XB), (pg8::ssq_t*)(ws + WS_CTL + CTL_SS) + 1 * M, (unsigned char*)(ws + WS_XB8), 1.0f, (const pg8::ssq_t*)(ws + WS_CTL + CTL_SS) + 0 * M, pg8::I8_SA / pg8::X2_RMS_RATIO, nullptr};
    pg8::gemm_phase<pg8::EpiResid<2>, pg8::StaticOrder, PG8_ALIGN, PG8_SP2>(F.lds + RING_OFF, g, S, E, F.wave);
    } else {
    pg8::Gemm g; g.A = (const bf16*)(ws + WS_HID); g.Bt = (const bf16*)(ws + WS_W2) + (size_t)DM * DFF; g.M = M; g.N = DM; g.K = DFF / 2; g.lda = DFF / 2; g.ldb = DFF / 2; g.npg = 0; g.a_gstride = 0;
    pg8::StaticOrder S; S.init(g.M, g.N, F.G, (int)blockIdx.x);
    pg8::EpiResid<0, true> E{(const bf16*)(ws + WS_XB), (bf16*)(ws + WS_XB), (pg8::ssq_t*)(ws + WS_CTL + CTL_SS) + 3 * M, nullptr, pg8::HQ_R / (255.0f * pg8::I8_SW2), nullptr, 0.f, (const int*)(ws + WS_SS0)};
    pg8::gemm_phase<pg8::EpiResid<0, true>, pg8::StaticOrder, PG8_ALIGN, PG8_SP2, false, true>(F.lds + RING_OFF, g, S, E, F.wave);
    }
}

__global__ void __launch_bounds__(NWAVES * 64, 2) yoco_fwd(Args args) {
    extern __shared__ __attribute__((aligned(16))) unsigned char lds[];
    Frame F;
    F.lds = (LAS unsigned char*)lds;
    F.MISC = (volatile LAS unsigned*)(F.lds + MISC_OFF);
    F.wave = __builtin_amdgcn_readfirstlane((int)threadIdx.x >> 6);
    F.G = gridDim.x; { const int bx = blockIdx.x; F.vcu = (F.G % 8 == 0) ? (bx % 8) * (F.G / 8) + bx / 8 : bx; }
    F.ctl = (gu32*)(kargs()->ws + WS_CTL);
    for (int u = F.wave * 64 + lane_id(); u < (LDS_BYTES - LDSCTL_OFF) / 4; u += NWAVES * 64) ((LAS unsigned*)(F.lds + LDSCTL_OFF))[u] = 0u;
    __syncthreads();
    XcdBarrier bar; bar.bar = (unsigned*)(F.ctl + CW_BAR); bar.x = 0; bar.st = nullptr;
#define LEADER() (F.wave == 0 && lane_id() == 0)
    if (!MK_PER_PHASE) bar = xcd_barrier_post((unsigned*)(F.ctl + CW_BAR), F.MISC + 8, LEADER());
#define GRID_BAR() do { if (MK_PER_PHASE) { if (LEADER()) __hip_atomic_store(F.ctl + CW_TMO, 0xBADBA0u, RLX_AGENT); } else { xcd_barrier(bar, LEADER()); } } while (0)
#define LO (kargs()->ph_lo)
#define HI (kargs()->ph_hi)
#define IN(k) (STEP_ON(k) && LO <= (k) && (k) < HI)
#define SEAM(k) do { if (LO <= (k) && (k) + 1 < HI) GRID_BAR(); } while (0)

    if (IN(0)) { CArgs* ap = kargs(); Ptrs P;
        P.x = ap->in[0]; P.mem = ap->in[1]; P.a_norm = ap->in[2]; P.a_w_in = ap->in[3]; P.a_w_pg = ap->in[4]; P.a_scale = ap->in[5]; P.a_w_out = ap->in[6]; P.kv_norm = ap->in[7]; P.w_kv = ap->in[8];
        P.b_norm = ap->in[9]; P.b_w_in = ap->in[10]; P.b_w_out = ap->in[11]; P.mem_norm = ap->in[12]; P.w_mem_kv = ap->in[13]; P.mlp_norm = ap->in[14]; P.mlp_w1 = ap->in[15]; P.mlp_w2 = ap->in[16];
        P.rel_bias = ap->in[17]; P.final_norm = ap->in[18];
        p0_prologue(F, P, ap->ws); }
    SEAM(0);
    if (IN(1)) step_inproj<0>(F);
    SEAM(1);
    if (IN(2)) step_mixer<0>(F);
    SEAM(2);
    if (IN(4)) step_outproj<0>(F);
    SEAM(4);
    if (IN(5)) step_mlp1<0>(F);
    SEAM(5);
    if (IN(6)) step_mlp2<0>(F);
    SEAM(6);
    if (IN(7)) step_inproj<1>(F);
    SEAM(7);
    if (IN(8)) step_mixer<1>(F);
    SEAM(8);
    if (IN(9)) step_mix2<1>(F);
    SEAM(9);
    if (IN(10)) step_outproj<1>(F);
    SEAM(10);
    if (IN(11)) step_mlp1<1>(F);
    SEAM(11);
    if (IN(12)) step_mlp2<1>(F);
    SEAM(12);
    if (IN(13)) { CArgs* ap = kargs(); final_norm_phase(F, (const bf16*)(ap->ws + WS_XB), ap->out, ap->in[18], (const int*)(ap->ws + WS_CTL + CTL_EVCNT), (const int*)(ap->ws + WS_EV), ap->in[16] + (size_t)DFF * DM); }
#undef IN
#undef SEAM
}

extern "C" void kernel_launch(void* const* d_in, const int* in_sizes, int n_in, void* d_out, int out_size, void* d_ws, size_t ws_size, hipStream_t stream) {
    static int grid = 0;
    if (grid == 0) {
        if (n_in != 19 || in_sizes[0] != M * DM || out_size != M * DM || ws_size < WS_END) { fprintf(stderr, "kernel_launch: unexpected shapes (n_in %d, in0 %d, out %d, ws %zu); nothing launched\n", n_in, n_in > 0 ? in_sizes[0] : -1, out_size, ws_size); grid = -1; return; }
        int dev = 0, cus = 0, per_cu = 0;
        if (hipGetDevice(&dev) != hipSuccess || hipDeviceGetAttribute(&cus, hipDeviceAttributeMultiprocessorCount, dev) != hipSuccess) { fprintf(stderr, "kernel_launch: device query failed\n"); grid = -1; return; }
        if (hipFuncSetAttribute((const void*)yoco_fwd, hipFuncAttributeMaxDynamicSharedMemorySize, LDS_BYTES) != hipSuccess) { fprintf(stderr, "kernel_launch: hipFuncSetAttribute failed\n"); grid = -1; return; }
        if (hipOccupancyMaxActiveBlocksPerMultiprocessor(&per_cu, (const void*)yoco_fwd, NWAVES * 64, LDS_BYTES) != hipSuccess || per_cu < 1)
            fprintf(stderr, "kernel_launch: note: occupancy query reports %d workgroups per CU\n", per_cu);
        (void)hipGetLastError();
        grid = cus;
    }
    if (grid < 0) return;
    if (hipMemsetAsync((char*)d_ws + WS_CTL, 0, CTL_ZERO_BYTES, stream) != hipSuccess) { fprintf(stderr, "kernel_launch: memset failed\n"); return; }
    Args a{};
    for (int i = 0; i < 19; ++i) a.in[i] = (const float*)d_in[i];
    a.out = (float*)d_out; a.ws = (unsigned char*)d_ws;
#if MK_PER_PHASE
    for (int li = 0; li < N_STEPS; ++li) { a.ph_lo = li; a.ph_hi = li + 1; a.li = li;
        hipLaunchKernelGGL(yoco_fwd, dim3(grid), dim3(NWAVES * 64), LDS_BYTES, stream, a); }
#else
    a.ph_lo = 0; a.ph_hi = N_STEPS; a.li = 0;
    hipLaunchKernelGGL(yoco_fwd, dim3(grid), dim3(NWAVES * 64), LDS_BYTES, stream, a);
#endif
    const hipError_t le = hipPeekAtLastError();
    if (le != hipSuccess) fprintf(stderr, "kernel_launch: launch failed: %s\n", hipGetErrorName(le));
}
```

```cpp
#include <hip/hip_runtime.h>
#include <cstdio>
#include <cstdint>

#ifndef MK_PER_PHASE
#define MK_PER_PHASE 0
#endif

__device__ __forceinline__ int lane_id() { unsigned m = ~0u; asm volatile("" : "+s"(m)); return (int)__builtin_amdgcn_mbcnt_hi(m, __builtin_amdgcn_mbcnt_lo(m, 0u)); }
namespace pg8 {
#define PG8_LAS __attribute__((address_space(3)))
typedef unsigned short bf16_t;
typedef short bf16x8 __attribute__((ext_vector_type(8)));
typedef float f32x4 __attribute__((ext_vector_type(4)));
typedef unsigned u32x4 __attribute__((ext_vector_type(4)));
constexpr int BM = 256, BK = 64, HALF = 128, HTB = HALF * BK * 2  , STAGE_BYTES = 8 * HTB, NXCD = 8, WGM = 8;

__host__ __device__ __forceinline__ int lds_byte(int r, int c) { const int st = (r >> 4) * 2 + (c >> 5), rr = r & 15, cc = c & 31, ob = rr * 64 + cc * 2; return st * 1024 + (ob ^ (((ob >> 9) & 1) << 5)); }
__host__ __device__ __forceinline__ void stage_rc(int b, int& R, int& C) { const int st = b / 1024, sb = b % 1024, swz = sb ^ (((sb >> 9) & 1) << 5); R = (st >> 1) * 16 + swz / 64; C = (st & 1) * 32 + (swz % 64) / 2; }
__host__ __device__ __forceinline__ int perm32(int rho) { const int n = rho >> 4, i = rho & 15; return 8 * (i >> 2) + 4 * n + (i & 3); }

struct Unit { int pm, pn; };
struct Gemm { const bf16_t* A; const bf16_t* Bt; int M, N, K, lda, ldb, npg, a_gstride; };

struct StaticOrder {
    int nM, nN, nwg, G, c;
    __host__ __device__ void init(int M, int N, int G_, int c_) { nM = M / BM; nN = N / BM; nwg = nM * nN; G = G_; c = c_; }
    __host__ __device__ bool next(int i, Unit& u) const {
        const long L = (long)i * G + c; if (L >= nwg) return false;
        int wgid = (int)L; { const int q = nwg / NXCD, r = nwg % NXCD, xcd = wgid % NXCD, off = wgid / NXCD; wgid = (xcd < r ? xcd * (q + 1) : r * (q + 1) + (xcd - r) * q) + off; }
        const int nig = WGM * nN, gid = wgid / nig, fm = gid * WGM, gsz = (nM - fm) < WGM ? (nM - fm) : WGM;
        u.pm = fm + ((wgid % nig) % gsz); u.pn = (wgid % nig) / gsz; return true;
    }
    __device__ __forceinline__ void a_ready(const Unit&) const {}
    __device__ __forceinline__ void done(const Unit&) const {}
};

__device__ __forceinline__ unsigned cvt_pk_bf16(float lo, float hi) { unsigned r; asm volatile("v_cvt_pk_bf16_f32 %0, %1, %2" : "=v"(r) : "v"(lo), "v"(hi)); return r; }

constexpr float RMS_EPS = 1e-6f;
typedef unsigned long long ssq_t;
constexpr float SSQ_SCALE = 1048576.0f, SSQ_TO_MEAN = 1.0f / (1048576.0f * 4096.0f);
__device__ __forceinline__ ssq_t ssq_from(float s) { return (ssq_t)(s * SSQ_SCALE + 0.5f); }
__device__ __forceinline__ float rstd_of(ssq_t s) { return __builtin_amdgcn_rsqf((float)s * SSQ_TO_MEAN + RMS_EPS); }
typedef int i32x4 __attribute__((ext_vector_type(4)));
constexpr float I8_SW2 = 127.0f * 128.0f / 4.0f;
constexpr float I8_SW = 127.0f * 64.0f / 4.0f;
constexpr float I8_SA = 127.0f / 4.0f;
constexpr float X1_RMS_RATIO = 1.256f;
constexpr float X2_RMS_RATIO = 1.40f;
__device__ __forceinline__ float rms_of(ssq_t s) { return __builtin_sqrtf((float)s * SSQ_TO_MEAN + RMS_EPS); }
__device__ __forceinline__ unsigned q8(float v) { return (unsigned)(int)__builtin_rintf(__builtin_amdgcn_fmed3f(v, -127.0f, 127.0f)) & 255u; }
__device__ __forceinline__ unsigned pack_q8(float a, float b, float c, float d) { return q8(a) | (q8(b) << 8) | (q8(c) << 16) | (q8(d) << 24); }
constexpr int EV_MAX = 8;
constexpr float HQ_R = 17.0f;
template <int ACT, bool IACC = false, int OQ = 0> struct EpiScaleBf16 {
    static constexpr bool PERM = true, AFTER_DRAIN = false, CINIT = false;
    int* evcnt; int* ev;
    bf16_t* O; int ldc; const ssq_t* ss; float mul; const ssq_t* ssq;
    __device__ __forceinline__ void operator()(const f32x4 (&acc)[2][2][4][2], const Unit& u, int wr, int wc, int fr, int fq) const {
        const int row0 = u.pm * BM + wr * 64 + fr, col0 = u.pn * BM + wc * 32 + 8 * fq;
        float rs[2][4];
#pragma unroll
        for (int ai = 0; ai < 2; ++ai)
#pragma unroll
            for (int m = 0; m < 4; ++m) { rs[ai][m] = (ss ? rstd_of(ss[row0 + ai * HALF + m * 16]) : 1.0f) * mul;
                if constexpr (IACC) { if (ssq) rs[ai][m] *= rms_of(ssq[row0 + ai * HALF + m * 16]); } }
#pragma unroll
        for (int ai = 0; ai < 2; ++ai)
#pragma unroll
            for (int m = 0; m < 4; ++m) { bf16_t* rowp = O + (size_t)(row0 + ai * HALF + m * 16) * ldc + col0; const float r = rs[ai][m];
#pragma unroll
                for (int bj = 0; bj < 2; ++bj) { f32x4 v0, v1;
                    if constexpr (IACC) { const i32x4 i0 = __builtin_bit_cast(i32x4, acc[ai][bj][m][0]), i1 = __builtin_bit_cast(i32x4, acc[ai][bj][m][1]);
                        v0 = (f32x4){(float)i0[0], (float)i0[1], (float)i0[2], (float)i0[3]} * r; v1 = (f32x4){(float)i1[0], (float)i1[1], (float)i1[2], (float)i1[3]} * r; }
                    else { v0 = acc[ai][bj][m][0] * r; v1 = acc[ai][bj][m][1] * r; }
                    if (ACT == 1) {
#pragma unroll
                        for (int j = 0; j < 4; ++j) { const float a = fmaxf(v0[j], 0.f), b = fmaxf(v1[j], 0.f); v0[j] = a * a; v1[j] = b * b; } }
                    if constexpr (OQ == 1) { typedef unsigned v2u_t __attribute__((ext_vector_type(2))); constexpr float s = 255.0f / HQ_R;
#define PG8_HQ(v) ((unsigned)(int)__builtin_rintf(__builtin_fminf((v) * s, 255.0f)))
                        const unsigned q0 = (PG8_HQ(v0[0]) | (PG8_HQ(v0[1]) << 8) | (PG8_HQ(v0[2]) << 16) | (PG8_HQ(v0[3]) << 24)) ^ 0x80808080u;
                        const unsigned q1 = (PG8_HQ(v1[0]) | (PG8_HQ(v1[1]) << 8) | (PG8_HQ(v1[2]) << 16) | (PG8_HQ(v1[3]) << 24)) ^ 0x80808080u;
#undef PG8_HQ
                        *(v2u_t*)((unsigned char*)O + (size_t)(row0 + ai * HALF + m * 16) * ldc + col0 + bj * HALF) = (v2u_t){q0, q1};
                        const float vmx = fmaxf(fmaxf(fmaxf(v0[0], v0[1]), fmaxf(v0[2], v0[3])), fmaxf(fmaxf(v1[0], v1[1]), fmaxf(v1[2], v1[3])));
                        if (vmx > HQ_R) {
                            const int row = row0 + ai * HALF + m * 16;
#pragma unroll
                            for (int j = 0; j < 8; ++j) { const float v = j < 4 ? v0[j & 3] : v1[j & 3];
                                if (v > HQ_R) { const int idx = __hip_atomic_fetch_add(evcnt + row, 1, __ATOMIC_RELAXED, __HIP_MEMORY_SCOPE_AGENT);
                                    if (idx < EV_MAX) { typedef int v2i_t __attribute__((ext_vector_type(2))); *(v2i_t*)(ev + ((size_t)row * EV_MAX + idx) * 2) = (v2i_t){col0 + bj * HALF + j, __builtin_bit_cast(int, v - HQ_R)}; } } }
                        }
                    } else {
                    u32x4 w; w.x = cvt_pk_bf16(v0[0], v0[1]); w.y = cvt_pk_bf16(v0[2], v0[3]); w.z = cvt_pk_bf16(v1[0], v1[1]); w.w = cvt_pk_bf16(v1[2], v1[3]);
                    *(u32x4*)(rowp + bj * HALF) = w; } } }
    }
};
template <int XQ = 0, bool IACC = false> struct EpiResid {
    static constexpr bool PERM = true, AFTER_DRAIN = false, CINIT = IACC;
    const bf16_t* xin; bf16_t* xout; ssq_t* ss; unsigned char* x8; float mul; const ssq_t* qss; float qmul; const int* cs;
    __device__ __forceinline__ void init_acc(f32x4 (&acc)[2][2][4][2], const Unit& u, int wc, int fq) const {
#pragma unroll
        for (int bj = 0; bj < 2; ++bj)
#pragma unroll
            for (int n = 0; n < 2; ++n) { const i32x4 c = *(const i32x4*)(cs + u.pn * BM + bj * HALF + wc * 32 + 8 * fq + 4 * n);
#pragma unroll
                for (int ai = 0; ai < 2; ++ai)
#pragma unroll
                    for (int m = 0; m < 4; ++m) acc[ai][bj][m][n] = __builtin_bit_cast(f32x4, c); }
    }
    __device__ __forceinline__ void operator()(const f32x4 (&acc)[2][2][4][2], const Unit& u, int wr, int wc, int fr, int fq) const {
        const int row0 = u.pm * BM + wr * 64 + fr, col0 = u.pn * BM + wc * 32 + 8 * fq;
#pragma unroll
        for (int ai = 0; ai < 2; ++ai) {
            u32x4 xr[4][2];
#pragma unroll
            for (int m = 0; m < 4; ++m)
#pragma unroll
                for (int bj = 0; bj < 2; ++bj) xr[m][bj] = *(const u32x4*)(xin + (size_t)(row0 + ai * HALF + m * 16) * 4096 + col0 + bj * HALF);
#pragma unroll
            for (int m = 0; m < 4; ++m) { const int row = row0 + ai * HALF + m * 16; const size_t off = (size_t)row * 4096 + col0; float sq = 0.f;
                float qs = 0.f; if constexpr (XQ == 2) qs = rstd_of(qss[row]) * qmul;
#pragma unroll
                for (int bj = 0; bj < 2; ++bj) { const u32x4 x = xr[m][bj];
                    const f32x4 a0 = {__builtin_bit_cast(float, x.x << 16), __builtin_bit_cast(float, x.x & 0xffff0000u), __builtin_bit_cast(float, x.y << 16), __builtin_bit_cast(float, x.y & 0xffff0000u)};
                    const f32x4 a1 = {__builtin_bit_cast(float, x.z << 16), __builtin_bit_cast(float, x.z & 0xffff0000u), __builtin_bit_cast(float, x.w << 16), __builtin_bit_cast(float, x.w & 0xffff0000u)};
                    f32x4 c0, c1;
                    if constexpr (IACC) { const i32x4 i0 = __builtin_bit_cast(i32x4, acc[ai][bj][m][0]), i1 = __builtin_bit_cast(i32x4, acc[ai][bj][m][1]);
                        c0 = (f32x4){(float)i0[0], (float)i0[1], (float)i0[2], (float)i0[3]}; c1 = (f32x4){(float)i1[0], (float)i1[1], (float)i1[2], (float)i1[3]}; }
                    else { c0 = acc[ai][bj][m][0]; c1 = acc[ai][bj][m][1]; }
                    const f32x4 v0 = c0 * mul + a0, v1 = c1 * mul + a1;
                    u32x4 w; w.x = cvt_pk_bf16(v0[0], v0[1]); w.y = cvt_pk_bf16(v0[2], v0[3]); w.z = cvt_pk_bf16(v1[0], v1[1]); w.w = cvt_pk_bf16(v1[2], v1[3]); *(u32x4*)(xout + off + bj * HALF) = w;
                    if constexpr (XQ == 2) { typedef unsigned v2u_t __attribute__((ext_vector_type(2)));
                        *(v2u_t*)(x8 + off + bj * HALF) = (v2u_t){pack_q8(v0[0] * qs, v0[1] * qs, v0[2] * qs, v0[3] * qs), pack_q8(v1[0] * qs, v1[1] * qs, v1[2] * qs, v1[3] * qs)}; }
                    if constexpr (XQ == 1) { int p0 = __builtin_amdgcn_cvt_pk_fp8_f32(v0[0], v0[1], 0, false); p0 = __builtin_amdgcn_cvt_pk_fp8_f32(v0[2], v0[3], p0, true);
                        int p1 = __builtin_amdgcn_cvt_pk_fp8_f32(v1[0], v1[1], 0, false); p1 = __builtin_amdgcn_cvt_pk_fp8_f32(v1[2], v1[3], p1, true);
                        typedef int v2i_t __attribute__((ext_vector_type(2))); *(v2i_t*)(x8 + off + bj * HALF) = (v2i_t){p0, p1}; }
                    sq += (v0[0] * v0[0] + v0[1] * v0[1]) + (v0[2] * v0[2] + v0[3] * v0[3]) + (v1[0] * v1[0] + v1[1] * v1[1]) + (v1[2] * v1[2] + v1[3] * v1[3]); }
                sq += __shfl_xor(sq, 16); sq += __shfl_xor(sq, 32);
                if (fq == 0) __hip_atomic_fetch_add(ss + row, ssq_from(sq), __ATOMIC_RELAXED, __HIP_MEMORY_SCOPE_AGENT); }
            asm volatile("" ::: "memory");
        }
    }
};

typedef int v4i_t __attribute__((ext_vector_type(4)));
typedef int v8i_t __attribute__((ext_vector_type(8)));
__device__ __forceinline__ v8i_t cat8(const bf16x8 lo, const bf16x8 hi) { return __builtin_shufflevector(__builtin_bit_cast(v4i_t, lo), __builtin_bit_cast(v4i_t, hi), 0, 1, 2, 3, 4, 5, 6, 7); }
template <class Epi, class Sched, bool ALIGN_EPI = false, bool SP2 = false, bool F8 = false, bool I8 = false>
__device__ __forceinline__ void gemm_phase(PG8_LAS unsigned char* lds, const Gemm g, const Sched& S, const Epi& E, const int wid  ) {
    const int lane = lane_id(), tid = wid * 64 + lane, wr = wid >> 2, wc = wid & 3, fr = lane & 15, fq = lane >> 4;
    const int K = g.K, nt = K / BK;
    unsigned voffA[2], voffB[2];
#pragma unroll
    for (int i = 0; i < 2; ++i) { int R, C; stage_rc(tid * 16 + i * 8192, R, C); const int Rb = Epi::PERM ? ((R & ~31) + perm32(R & 31)) : R;
        voffA[i] = (unsigned)(R * g.lda + C) * 2u; voffB[i] = (unsigned)(Rb * g.ldb + C) * 2u; }
    const size_t kstep = (size_t)(BK * 2);
    const size_t hstepA = (size_t)HALF * g.lda * 2, hstepB = (size_t)HALF * g.ldb * 2;
    const size_t tstepA = 2 * hstepA, tstepB = 2 * hstepB;
    const unsigned ldsw = (unsigned)wid * 1024u;
    const int aoff = lds_byte(wr * 64 + fr, fq * 8), boff = lds_byte(wc * 32 + fr, fq * 8);
#define PG8_SA(b, h) (((b) * 2 + (h)) * HTB)
#define PG8_SB(b, h) ((4 + (b) * 2 + (h)) * HTB)
#define PG8_STAGE(bufoff, gbase, voff) do { _Pragma("unroll") for (int _i = 0; _i < 2; ++_i) \
        __builtin_amdgcn_global_load_lds((const unsigned*)((const char*)(gbase) + (voff)[_i]), (PG8_LAS unsigned*)(lds + (bufoff) + ldsw + _i * 8192), 16, 0, 0); } while (0)
#define PG8_LDA(dst, b, h) do { _Pragma("unroll") for (int m = 0; m < 4; ++m) { \
        if constexpr (F8) dst##8[m] = cat8(*(const PG8_LAS bf16x8*)(lds + PG8_SA(b, h) + aoff + m * 2048), *(const PG8_LAS bf16x8*)(lds + PG8_SA(b, h) + aoff + m * 2048 + 1024)); \
        else { _Pragma("unroll") for (int k = 0; k < 2; ++k) dst[m][k] = *(const PG8_LAS bf16x8*)(lds + PG8_SA(b, h) + aoff + m * 2048 + k * 1024); } } } while (0)
#define PG8_LDB(dst, b, h) do { _Pragma("unroll") for (int n = 0; n < 2; ++n) { \
        if constexpr (F8) dst##8[n] = cat8(*(const PG8_LAS bf16x8*)(lds + PG8_SB(b, h) + boff + n * 2048), *(const PG8_LAS bf16x8*)(lds + PG8_SB(b, h) + boff + n * 2048 + 1024)); \
        else { _Pragma("unroll") for (int k = 0; k < 2; ++k) dst[n][k] = *(const PG8_LAS bf16x8*)(lds + PG8_SB(b, h) + boff + n * 2048 + k * 1024); } } } while (0)
#define PG8_MMA(ai, bj, At, Bt) do { __builtin_amdgcn_s_setprio(1); \
        if constexpr (F8) { _Pragma("unroll") for (int m = 0; m < 4; ++m) _Pragma("unroll") for (int n = 0; n < 2; ++n) \
            asm volatile("v_mfma_scale_f32_16x16x128_f8f6f4 %0, %1, %2, %0, %3, %3 op_sel_hi:[0,0,0]" : "+v"(acc[ai][bj][m][n]) : "v"(Bt##8[n]), "v"(At##8[m]), "v"(one_scale)); } \
        else if constexpr (I8) { _Pragma("unroll") for (int m = 0; m < 4; ++m) _Pragma("unroll") for (int n = 0; n < 2; ++n) _Pragma("unroll") for (int k = 0; k < 2; ++k) \
            acc[ai][bj][m][n] = __builtin_bit_cast(f32x4, __builtin_amdgcn_mfma_i32_16x16x64_i8(__builtin_bit_cast(v4i_t, Bt[n][k]), __builtin_bit_cast(v4i_t, At[m][k]), __builtin_bit_cast(v4i_t, acc[ai][bj][m][n]), 0, 0, 0)); } \
        else { _Pragma("unroll") for (int m = 0; m < 4; ++m) _Pragma("unroll") for (int n = 0; n < 2; ++n) _Pragma("unroll") for (int k = 0; k < 2; ++k) \
            acc[ai][bj][m][n] = __builtin_amdgcn_mfma_f32_16x16x32_bf16(Bt[n][k], At[m][k], acc[ai][bj][m][n], 0, 0, 0); } \
        __builtin_amdgcn_s_setprio(0); } while (0)
#define PG8_WAIT_V(n) asm volatile("s_waitcnt vmcnt(" #n ")" ::: "memory")
#define PG8_WAIT_L(n) asm volatile("s_waitcnt lgkmcnt(" #n ")" ::: "memory")
#define PG8_BAR __builtin_amdgcn_s_barrier()
#define PG8_SCHED __builtin_amdgcn_sched_barrier(0)
#define PG8_ABASE(u) ((const char*)g.A + (size_t)(u).pm * tstepA + (g.npg ? (size_t)((u).pn / g.npg) * (size_t)g.a_gstride : (size_t)0))
    Unit cur, nxt; int ui = 0;
    if (!S.next(0, cur)) return;
    f32x4 acc[2][2][4][2];
    if constexpr (Epi::CINIT) E.init_acc(acc, cur, wc, fq);
    else {
#pragma unroll
    for (int a = 0; a < 2; ++a)
#pragma unroll
        for (int b = 0; b < 2; ++b)
#pragma unroll
            for (int m = 0; m < 4; ++m)
#pragma unroll
                for (int n = 0; n < 2; ++n) acc[a][b][m][n] = (f32x4){0.f, 0.f, 0.f, 0.f};
    }
    bf16x8 At[4][2], B0[2][2], B1[2][2];
    v8i_t At8[4], B08[2], B18[2];
    const int one_scale = 0x7F7F7F7F;
    const char* cA = PG8_ABASE(cur); const char* cB = (const char*)g.Bt + (size_t)cur.pn * tstepB;
    S.a_ready(cur);
    if constexpr (SP2) {
        PG8_STAGE(PG8_SB(0, 0), cB, voffB); PG8_STAGE(PG8_SB(0, 1), cB + hstepB, voffB); PG8_STAGE(PG8_SA(0, 0), cA, voffA); PG8_STAGE(PG8_SA(0, 1), cA + hstepA, voffA);
        if (wr == 1) PG8_BAR;
        PG8_WAIT_V(2); PG8_BAR;
        PG8_STAGE(PG8_SB(1, 0), cB + kstep, voffB); PG8_STAGE(PG8_SA(1, 0), cA + kstep, voffA); PG8_STAGE(PG8_SB(1, 1), cB + hstepB + kstep, voffB);
        PG8_WAIT_V(6); PG8_BAR;
    } else {
        PG8_STAGE(PG8_SB(0, 0), cB, voffB); PG8_STAGE(PG8_SA(0, 0), cA, voffA); PG8_STAGE(PG8_SB(0, 1), cB + hstepB, voffB); PG8_STAGE(PG8_SA(0, 1), cA + hstepA, voffA);
        if (wr == 1) PG8_BAR;
        PG8_WAIT_V(4); PG8_BAR;
        PG8_STAGE(PG8_SB(1, 0), cB + kstep, voffB); PG8_STAGE(PG8_SA(1, 0), cA + kstep, voffA); PG8_STAGE(PG8_SB(1, 1), cB + hstepB + kstep, voffB);
        PG8_WAIT_V(6); PG8_BAR;
    }
    for (;;) {
        const bool has_next = S.next(ui + 1, nxt);
        const char* nA = has_next ? PG8_ABASE(nxt) : cA; const char* nB = has_next ? (const char*)g.Bt + (size_t)nxt.pn * tstepB : cB;
        for (int t = 0; t < nt; t += 2) {
            const bool last = (t == nt - 2);
            const char* a1 = cA + (size_t)(t + 1) * kstep;
            const char* a2 = last ? nA : cA + (size_t)(t + 2) * kstep; const char* b2 = last ? nB : cB + (size_t)(t + 2) * kstep;
            const char* a3 = a2 + kstep; const char* b3 = b2 + kstep;
            if (last && has_next) S.a_ready(nxt);
            if constexpr (SP2) {
            PG8_LDB(B0, 0, 0); PG8_LDB(B1, 0, 1); PG8_SCHED; PG8_LDA(At, 0, 0); PG8_STAGE(PG8_SA(1, 1), a1 + hstepA, voffA);
            PG8_WAIT_V(8); PG8_WAIT_L(0); PG8_BAR; PG8_MMA(0, 0, At, B0); PG8_MMA(0, 1, At, B1); PG8_BAR; PG8_SCHED;
            PG8_LDA(At, 0, 1); PG8_STAGE(PG8_SB(0, 0), b2, voffB); PG8_STAGE(PG8_SB(0, 1), b2 + hstepB, voffB); PG8_STAGE(PG8_SA(0, 0), a2, voffA);
            PG8_WAIT_V(8); PG8_WAIT_L(0); PG8_BAR; PG8_MMA(1, 0, At, B0); PG8_MMA(1, 1, At, B1); PG8_BAR; PG8_SCHED;
            PG8_LDB(B0, 1, 0); PG8_LDB(B1, 1, 1); PG8_SCHED; PG8_LDA(At, 1, 0); PG8_STAGE(PG8_SA(0, 1), a2 + hstepA, voffA);
            PG8_WAIT_V(8); PG8_WAIT_L(0); PG8_BAR; PG8_MMA(0, 0, At, B0); PG8_MMA(0, 1, At, B1); PG8_BAR; PG8_SCHED;
            PG8_LDA(At, 1, 1); PG8_STAGE(PG8_SB(1, 0), b3, voffB); PG8_STAGE(PG8_SB(1, 1), b3 + hstepB, voffB); PG8_STAGE(PG8_SA(1, 0), a3, voffA);
            PG8_WAIT_V(8); PG8_WAIT_L(0); PG8_BAR; PG8_MMA(1, 0, At, B0); PG8_MMA(1, 1, At, B1); PG8_BAR; PG8_SCHED;
            } else {
            PG8_LDB(B0, 0, 0); PG8_SCHED; PG8_LDA(At, 0, 0); PG8_STAGE(PG8_SA(1, 1), a1 + hstepA, voffA);
            PG8_WAIT_L(8); PG8_BAR; PG8_WAIT_L(0); PG8_MMA(0, 0, At, B0); PG8_BAR; PG8_SCHED;
            PG8_LDB(B1, 0, 1); PG8_STAGE(PG8_SB(0, 0), b2, voffB);
            PG8_BAR; PG8_WAIT_L(0); PG8_MMA(0, 1, At, B1); PG8_BAR;
            PG8_LDA(At, 0, 1); PG8_STAGE(PG8_SA(0, 0), a2, voffA);
            PG8_BAR; PG8_WAIT_L(0); PG8_MMA(1, 0, At, B0); PG8_BAR; PG8_SCHED;
            PG8_STAGE(PG8_SB(0, 1), b2 + hstepB, voffB);
            PG8_WAIT_V(6); PG8_BAR; PG8_MMA(1, 1, At, B1); PG8_BAR;
            PG8_LDB(B0, 1, 0); PG8_SCHED; PG8_LDA(At, 1, 0); PG8_STAGE(PG8_SA(0, 1), a2 + hstepA, voffA);
            PG8_WAIT_L(8); PG8_BAR; PG8_WAIT_L(0); PG8_MMA(0, 0, At, B0); PG8_BAR; PG8_SCHED;
            PG8_LDB(B1, 1, 1); PG8_STAGE(PG8_SB(1, 0), b3, voffB);
            PG8_BAR; PG8_WAIT_L(0); PG8_MMA(0, 1, At, B1); PG8_BAR;
            PG8_LDA(At, 1, 1); PG8_STAGE(PG8_SA(1, 0), a3, voffA);
            PG8_BAR; PG8_WAIT_L(0); PG8_MMA(1, 0, At, B0); PG8_BAR; PG8_SCHED;
            PG8_STAGE(PG8_SB(1, 1), b3 + hstepB, voffB);
            PG8_WAIT_V(6); PG8_BAR; PG8_MMA(1, 1, At, B1); PG8_BAR;
            }
        }
        if constexpr (ALIGN_EPI) { if (wr == 0) PG8_BAR; }
        if constexpr (F8) asm volatile("s_nop 7\n\ts_nop 7\n\ts_nop 7" ::: "memory");
        if constexpr (!Epi::AFTER_DRAIN) { E(acc, cur, wr, wc, fr, fq); S.done(cur); }
        if (!has_next) break;
        if constexpr (Epi::CINIT) E.init_acc(acc, nxt, wc, fq);
        else {
#pragma unroll
        for (int a = 0; a < 2; ++a)
#pragma unroll
            for (int b = 0; b < 2; ++b)
#pragma unroll
                for (int m = 0; m < 4; ++m)
#pragma unroll
                    for (int n = 0; n < 2; ++n) acc[a][b][m][n] = (f32x4){0.f, 0.f, 0.f, 0.f};
        }
        cur = nxt; cA = nA; cB = nB; ++ui;
        if constexpr (ALIGN_EPI) { if (wr == 1) PG8_BAR; }
    }
    PG8_WAIT_V(0);
    if constexpr (!ALIGN_EPI) { if (wr == 0) PG8_BAR; }
    PG8_BAR;
#undef PG8_SA
#undef PG8_SB
#undef PG8_STAGE
#undef PG8_LDA
#undef PG8_LDB
#undef PG8_MMA
#undef PG8_WAIT_V
#undef PG8_WAIT_L
#undef PG8_BAR
#undef PG8_SCHED
#undef PG8_ABASE
}
}

#ifndef PG8_SP2
#define PG8_SP2 true
#endif
#ifndef PG8_ALIGN
#define PG8_ALIGN true
#endif

constexpr int NWAVES = 8;
constexpr int BATCH = 8, SEQ = 2048, DM = 4096, M = BATCH * SEQ, MEMLEN = 256, MMEM = BATCH * MEMLEN, DFF = 16384;
constexpr int POOLW = 3072, POOLG = 768, KVW = 6144, KVUW = 10240;
constexpr int NQ0 = 12288;

constexpr size_t MiB = 1u << 20;
constexpr size_t WS_CTL = 0, CTL_ZERO_BYTES = 1 * MiB;
constexpr size_t CTL_EVCNT = 768 * 1024;
constexpr size_t CTL_SS = 256 * 1024;
constexpr size_t WS_SS0 = 1 * MiB;
constexpr size_t WS_SSQ0 = 3 * MiB + 512 * 1024;
constexpr size_t WS_LSE = 2 * MiB;
constexpr size_t WS_EV = WS_LSE;
constexpr size_t WS_MKV = 4 * MiB;
constexpr size_t WS_MEMB = 20 * MiB;
constexpr size_t WS_WPG = 36 * MiB;
constexpr size_t WS_WAIN = 42 * MiB;
constexpr size_t WS_WMEMKV = 74 * MiB;
constexpr size_t WS_WAOUT = 106 * MiB;
constexpr size_t WS_XB8 = 900 * MiB;
constexpr size_t WS_WOUTP = 874 * MiB;
constexpr size_t WS_WKVB = 138 * MiB;
constexpr size_t WS_WBOUT = 218 * MiB;
constexpr size_t WS_W1 = 234 * MiB;
constexpr size_t WS_W2 = 490 * MiB;
constexpr size_t WS_XB = 746 * MiB;
constexpr size_t WS_X1 = 874 * MiB;
constexpr size_t WS_R = 1130 * MiB;
constexpr size_t WS_HID = WS_R;
constexpr size_t WS_U = WS_R, WS_POOLED = WS_R + 128 * MiB, WS_CAT = WS_R + 224 * MiB;
constexpr size_t WS_KVU = WS_R, WS_OG = WS_R + 320 * MiB, WS_CAT2 = WS_R + 416 * MiB;
constexpr size_t WS_END = 1642 * MiB;
constexpr int CW_TMO = 0, CW_CODE = 1, CW_BAR = 4096;

constexpr int RING_OFF = 0, RING_BYTES = 131072;
constexpr int LDSCTL_OFF = 143360, MISC_OFF = LDSCTL_OFF + 320;
constexpr int LDS_BYTES = 147456;

#define GAS __attribute__((address_space(1)))
#define LAS __attribute__((address_space(3)))
typedef unsigned short bf16;
typedef unsigned v4u __attribute__((ext_vector_type(4)));
typedef unsigned v2u __attribute__((ext_vector_type(2)));
typedef float f32x4 __attribute__((ext_vector_type(4)));
typedef short bf16x8 __attribute__((ext_vector_type(8)));
typedef short s16x4 __attribute__((ext_vector_type(4)));
typedef GAS unsigned gu32;
#define RLX_AGENT __ATOMIC_RELAXED, __HIP_MEMORY_SCOPE_AGENT
#define LDS_WAIT() asm volatile("s_waitcnt lgkmcnt(0)" ::: "memory")
#define VM_WAIT() asm volatile("s_waitcnt vmcnt(0)" ::: "memory")
__device__ __forceinline__ unsigned f2bf(float f) { unsigned u = __builtin_bit_cast(unsigned, f); return (u + 0x7fffu + ((u >> 16) & 1u)) >> 16; }
__device__ __forceinline__ unsigned pk2(float lo, float hi) { return f2bf(lo) | (f2bf(hi) << 16); }
__device__ __forceinline__ float bflo(unsigned w) { return __builtin_bit_cast(float, w << 16); }
__device__ __forceinline__ float bfhi(unsigned w) { return __builtin_bit_cast(float, w & 0xffff0000u); }

#define XB_TMO      128
#define XB_XCNT(j)  (256  + 64 * (j))
#define XB_XSUB(j)  (1280 + 64 * (j))
#define XB_XGEN(j)  (2304 + 64 * (j))
#define XB_TOP      3328
#define XB_TOPGEN   3392
#define XCD_BAR_WORDS 3456
#define XB_SPIN_CAP (1u << 22)
__device__ __forceinline__ unsigned xb_ld(unsigned* p)              { return __hip_atomic_load(p, __ATOMIC_RELAXED, __HIP_MEMORY_SCOPE_AGENT); }
__device__ __forceinline__ unsigned xb_add(unsigned* p, unsigned v) { return __hip_atomic_fetch_add(p, v, __ATOMIC_RELAXED, __HIP_MEMORY_SCOPE_AGENT); }
__device__ __forceinline__ unsigned xb_xcc_id() { return (unsigned)__builtin_amdgcn_s_getreg((3 << 11) | 20) & 0xFu; }
#define XB_SPIN(cond, bar) do { unsigned _sp = 0; while (cond) { __builtin_amdgcn_s_sleep(1); \
    if ((++_sp & 255u) == 0u) { if (xb_ld(&(bar)[XB_TMO])) break; if (_sp > XB_SPIN_CAP) { atomicAdd(&(bar)[XB_TMO], 1u); break; } } } } while (0)
struct XcdBarrier { unsigned* bar; unsigned x; volatile LAS unsigned* st; };
__device__ __forceinline__ XcdBarrier xcd_barrier_post(unsigned* bar, volatile LAS unsigned* st, bool leader  ) {
    XcdBarrier b; b.bar = bar; b.x = xb_xcc_id(); b.st = st;
    if (leader) (void)xb_add(&bar[XB_XCNT(b.x)], 1u);
    return b;
}
__device__ __forceinline__ void xcd_barrier_complete(unsigned* bar, unsigned x, unsigned& nloc, unsigned& nx) {
    const unsigned G = gridDim.x * gridDim.y * gridDim.z;
    unsigned sum, cnt, mine, sp = 0u;
    for (;;) {
        sum = 0u; cnt = 0u; mine = 0u;
#pragma unroll
        for (unsigned j = 0; j < 16; ++j) { const unsigned c = xb_ld(&bar[XB_XCNT(j)]); sum += c; cnt += (c > 0u) ? 1u : 0u; mine = (j == x) ? c : mine; }
        if (sum == G) break;
        __builtin_amdgcn_s_sleep(1);
        if ((++sp & 255u) == 0u) { if (xb_ld(&bar[XB_TMO])) break; if (sp > XB_SPIN_CAP) { atomicAdd(&bar[XB_TMO], 1u); break; } }
    }
    nloc = mine > 0u ? mine : 1u; nx = cnt > 0u ? cnt : 1u;
}
__device__ __forceinline__ void xcd_barrier(const XcdBarrier& b, bool leader  ) {
    asm volatile("s_waitcnt vmcnt(0)" ::: "memory");
    __syncthreads();
    if (leader) {
        unsigned* bar = b.bar;
        __builtin_amdgcn_s_waitcnt(0);
        unsigned nloc = b.st[0], nx = b.st[1];
        if (nloc == 0u) { xcd_barrier_complete(bar, b.x, nloc, nx); b.st[0] = nloc; b.st[1] = nx; }
        const unsigned old = xb_add(&bar[XB_XSUB(b.x)], 1u);
        const unsigned gen = old / nloc;
        if (old + 1u == (gen + 1u) * nloc) {
            __builtin_amdgcn_fence(__ATOMIC_RELEASE, "agent");
            asm volatile("s_waitcnt vmcnt(0)" ::: "memory");
            const unsigned og = xb_add(&bar[XB_TOP], 1u);
            const unsigned tg = og / nx;
            if (og + 1u == (tg + 1u) * nx) xb_add(&bar[XB_TOPGEN], 1u);
            else XB_SPIN(xb_ld(&bar[XB_TOPGEN]) == tg, bar);
            __builtin_amdgcn_fence(__ATOMIC_ACQUIRE, "agent");
            xb_add(&bar[XB_XGEN(b.x)], 1u);
            asm volatile("s_waitcnt vmcnt(0)" ::: "memory");
        } else {
            XB_SPIN(xb_ld(&bar[XB_XGEN(b.x)]) == gen, bar);
            __builtin_amdgcn_fence(__ATOMIC_ACQUIRE, "agent");
            asm volatile("s_waitcnt vmcnt(0)" ::: "memory");
        }
    }
    __syncthreads();
}

struct Frame {
    LAS unsigned char* lds;
    volatile LAS unsigned* MISC;
    gu32* ctl;
    int wave;
    int vcu, G;
};

__device__ __forceinline__ float wave_sum(float v) {
#pragma unroll
    for (int o = 1; o < 64; o <<= 1) v += __shfl_xor(v, o);
    return v;
}
template <int Q = 0>
__device__ __forceinline__ void p0_transpose_item(const float* W, int N, bf16* WT, int ldo, int row_off, const float* gk, const float* gn, LAS float* scr, int item, int lane, float qscale = pg8::I8_SW, int ncol = 0) {
    constexpr bool F8 = (Q != 0);
    const int nblk = (ncol ? ncol : N) / 64, kb = item / nblk, nb = item % nblk, n0 = 64 * nb;
    const int lr = lane >> 4, lq = lane & 15;
    const int c = lane & 7, nn = lane >> 3;
#pragma unroll 1
    for (int h = 0; h < (F8 ? 2 : 1); ++h) {
    const int k0 = F8 ? 128 * kb + 64 * h : 64 * kb;
    const float* src = W + (size_t)(k0 + lr) * N + n0 + 4 * lq;
    f32x4 v[16];
#pragma unroll
    for (int i = 0; i < 16; ++i) v[i] = *(const GAS f32x4*)(src + (size_t)(4 * i) * N);
    float gkv[8];
#pragma unroll
    for (int e = 0; e < 8; ++e) gkv[e] = gk ? gk[k0 + 8 * c + e] : 1.0f;
#pragma unroll
    for (int i = 0; i < 16; ++i) { LAS float* d = scr + (4 * i + lr) * 65 + 4 * lq; d[0] = v[i].x; d[1] = v[i].y; d[2] = v[i].z; d[3] = v[i].w; }
    LDS_WAIT(); asm volatile("" ::: "memory");
#pragma unroll
    for (int j = 0; j < 8; ++j) { const int n = 8 * j + nn; const LAS float* s = scr + (8 * c) * 65 + n; const float gg = (gn ? gn[n0 + n] : 1.0f) * (Q == 1 ? 64.0f : (Q == 2 ? qscale : 1.0f));
        if constexpr (Q == 2) {
            *(GAS v2u*)((unsigned char*)WT + (size_t)(row_off + n0 + n) * ldo + k0 + 8 * c) = (v2u){pg8::pack_q8(s[0 * 65] * gkv[0] * gg, s[1 * 65] * gkv[1] * gg, s[2 * 65] * gkv[2] * gg, s[3 * 65] * gkv[3] * gg),
                                                                                                      pg8::pack_q8(s[4 * 65] * gkv[4] * gg, s[5 * 65] * gkv[5] * gg, s[6 * 65] * gkv[6] * gg, s[7 * 65] * gkv[7] * gg)};
        } else if constexpr (Q == 1) {
            int p0 = __builtin_amdgcn_cvt_pk_fp8_f32(s[0 * 65] * gkv[0] * gg, s[1 * 65] * gkv[1] * gg, 0, false); p0 = __builtin_amdgcn_cvt_pk_fp8_f32(s[2 * 65] * gkv[2] * gg, s[3 * 65] * gkv[3] * gg, p0, true);
            int p1 = __builtin_amdgcn_cvt_pk_fp8_f32(s[4 * 65] * gkv[4] * gg, s[5 * 65] * gkv[5] * gg, 0, false); p1 = __builtin_amdgcn_cvt_pk_fp8_f32(s[6 * 65] * gkv[6] * gg, s[7 * 65] * gkv[7] * gg, p1, true);
            *(GAS v2u*)((unsigned char*)WT + (size_t)(row_off + n0 + n) * ldo + k0 + 8 * c) = (v2u){(unsigned)p0, (unsigned)p1};
        } else {
        v4u o; o.x = pk2(s[0 * 65] * gkv[0] * gg, s[1 * 65] * gkv[1] * gg); o.y = pk2(s[2 * 65] * gkv[2] * gg, s[3 * 65] * gkv[3] * gg);
        o.z = pk2(s[4 * 65] * gkv[4] * gg, s[5 * 65] * gkv[5] * gg); o.w = pk2(s[6 * 65] * gkv[6] * gg, s[7 * 65] * gkv[7] * gg);
        *(GAS v4u*)(WT + (size_t)(row_off + n0 + n) * ldo + k0 + 8 * c) = o; } }
    LDS_WAIT(); asm volatile("" ::: "memory");
    }
}
__device__ __forceinline__ void row_to_bf16_ss(int lane, const float* xrow, bf16* orow, pg8::ssq_t* ssp) {
    const GAS f32x4* xr = (const GAS f32x4*)xrow + lane;
    GAS unsigned long long* o8 = (GAS unsigned long long*)orow + lane;
    float s = 0.f;
#pragma unroll
    for (int j = 0; j < 16; ++j) { const f32x4 v = xr[64 * j]; s += (v.x * v.x + v.y * v.y) + (v.z * v.z + v.w * v.w);
        o8[64 * j] = (unsigned long long)pk2(v.x, v.y) | ((unsigned long long)pk2(v.z, v.w) << 32); }
    s = wave_sum(s);
    if (lane == 0) *ssp = pg8::ssq_from(s);
}

struct Ptrs {
    const float *x, *mem, *a_norm, *a_w_in, *a_w_pg, *a_scale, *a_w_out, *kv_norm, *w_kv, *b_norm, *b_w_in, *b_w_out, *mem_norm, *w_mem_kv, *mlp_norm, *mlp_w1, *mlp_w2, *rel_bias, *final_norm;
};

__device__ __forceinline__ void p0_prologue(Frame& F, const Ptrs& P, unsigned char* ws) {
    const int lane = lane_id(), tid = F.wave * 64 + lane;
    LAS float* scr = (LAS float*)(F.lds + RING_OFF + F.wave * 16640);
    const int gw = F.vcu * NWAVES + F.wave, NGW = F.G * NWAVES;
    bf16* WAIN = (bf16*)(ws + WS_WAIN); bf16* WMEMKV = (bf16*)(ws + WS_WMEMKV); bf16* WPG = (bf16*)(ws + WS_WPG); bf16* WAOUT = (bf16*)(ws + WS_WAOUT);
    bf16* WKVB = (bf16*)(ws + WS_WKVB); bf16* WBOUT = (bf16*)(ws + WS_WBOUT); bf16* W1 = (bf16*)(ws + WS_W1); bf16* W2 = (bf16*)(ws + WS_W2);
    constexpr int I_SQ = (DM / 64) * (DM / 64);
    constexpr int I_MKV = (DM / 64) * (2048 / 64);
    constexpr int I_PG = (POOLG / 64) * (POOLG / 64);
    constexpr int I_W2 = (DFF / 64) * (DM / 64);
    constexpr int I_KV = (DM / 128) * (KVW / 64);
    constexpr int I_BIN = (DM / 128) * (DM / 64);
    constexpr int I_BO = (2048 / 128) * (DM / 64);
    constexpr int I_W1Q = (DM / 128) * (DFF / 64);
    constexpr int I_W2Q = (DFF / 128) * (DM / 64);
    constexpr int I_W1A = (DM / 128) * (NQ0 / 64), I_W1B = (DM / 64) * ((DFF - NQ0) / 64);
    constexpr int NITEMS = 2 * I_SQ + I_BIN + 2 * I_MKV + I_W1A + I_W1B + I_W1Q + I_W2 + I_W2Q + I_KV + I_BO;
    for (int it = gw; it < NITEMS; it += NGW) {
        int r = it;
        if (r < I_W1A) { p0_transpose_item<2>(P.mlp_w1, DFF, W1, DM, 0, P.mlp_norm, nullptr, scr, r, lane, pg8::I8_SW, NQ0); continue; } r -= I_W1A;
        if (r < I_W1B) { p0_transpose_item(P.mlp_w1 + NQ0, DFF, W1 + (size_t)32 * 1024 * 1024, DM, 0, P.mlp_norm, nullptr, scr, r, lane, 1.0f, DFF - NQ0); continue; } r -= I_W1B;
        if (r < I_W1Q) { p0_transpose_item<2>(P.mlp_w1 + (size_t)DM * DFF, DFF, W1 + (size_t)DFF * DM, DM, 0, P.mlp_norm + DM, nullptr, scr, r, lane); continue; } r -= I_W1Q;
        if (r < I_W2) { p0_transpose_item(P.mlp_w2, DM, W2, DFF, 0, nullptr, nullptr, scr, r, lane); continue; } r -= I_W2;
        if (r < I_W2Q) { p0_transpose_item<2>(P.mlp_w2 + (size_t)DFF * DM, DM, W2 + (size_t)DM * DFF, DFF, 0, nullptr, nullptr, scr, r, lane, pg8::I8_SW2); continue; } r -= I_W2Q;
        if (r < I_KV) { p0_transpose_item<2>(P.w_kv, KVW, WKVB, DM, 0, P.kv_norm, nullptr, scr, r, lane); continue; } r -= I_KV;
        if (r < I_BIN) { p0_transpose_item<2>(P.b_w_in, DM, WKVB, DM, KVW, P.b_norm, nullptr, scr, r, lane); continue; } r -= I_BIN;
        if (r < I_SQ) { p0_transpose_item(P.a_w_in, DM, WAIN, DM, 0, P.a_norm, nullptr, scr, r, lane); continue; } r -= I_SQ;
        if (r < I_SQ) { const bool poolrows = (r / (DM / 64)) * 64 < POOLW;
            p0_transpose_item(P.a_w_out, DM, poolrows ? (bf16*)(ws + WS_WOUTP) : WAOUT, poolrows ? POOLW : DM, 0, nullptr, nullptr, scr, r, lane); continue; } r -= I_SQ;
        if (r < 2 * I_MKV) { const int l = r / I_MKV; r -= l * I_MKV; p0_transpose_item(P.w_mem_kv + (size_t)l * DM * 2048, 2048, WMEMKV, DM, l * 2048, P.mem_norm, nullptr, scr, r, lane); continue; } r -= 2 * I_MKV;
        p0_transpose_item<1>(P.b_w_out, DM, WBOUT, 2048, 0, nullptr, nullptr, scr, r, lane);
    }
    bf16* XB = (bf16*)(ws + WS_XB); bf16* MEMB = (bf16*)(ws + WS_MEMB); pg8::ssq_t* ss0 = (pg8::ssq_t*)(ws + WS_SSQ0); pg8::ssq_t* ssm = (pg8::ssq_t*)(ws + WS_SSQ0 + 131072);
    for (int m = gw; m < M + MMEM + POOLW; m += NGW) {
        if (m < M) row_to_bf16_ss(lane, P.x + (size_t)m * DM, XB + (size_t)m * DM, ss0 + m);
        else if (m < M + MMEM) { const int mm = m - M; row_to_bf16_ss(lane, P.mem + (size_t)mm * DM, MEMB + (size_t)mm * DM, ssm + mm); }
        else { const int rr = m - M - MMEM, g = rr / POOLG;
            const GAS f32x4* wr_ = (const GAS f32x4*)(P.a_w_pg + (size_t)rr * POOLG) + lane; const GAS f32x4* sc = (const GAS f32x4*)(P.a_scale + g * POOLG) + lane;
            GAS unsigned long long* o8 = (GAS unsigned long long*)(WPG + (size_t)rr * POOLG) + lane;
#pragma unroll
            for (int j = 0; j < 3; ++j) { const f32x4 v = wr_[64 * j] * sc[64 * j]; o8[64 * j] = (unsigned long long)pk2(v.x, v.y) | ((unsigned long long)pk2(v.z, v.w) << 32); } }
    }
    float* BT = (float*)(ws + WS_SS0 + 131072);
    for (int i = (int)blockIdx.x * 512 + tid; i < 24 * 129; i += F.G * 512) {
        const int gh = i / 129, delta = i % 129, g = gh >> 3, dil = g == 0 ? 1 : (g == 1 ? 4 : 16), dist = delta * dil;
        int bucket = dist;
        if (dist >= 16) { const float d32 = (float)dist; int lg = 16 + (int)(logf(d32 / 16.0f) / 4.852030263919617f * 16.0f); bucket = lg < 31 ? lg : 31; }
        BT[i] = P.rel_bias[bucket * 24 + gh];
    }
}

template <int D> struct AttnItem {
    const bf16* q; size_t qstride;
    const bf16* k; const bf16* v; size_t kstride;
    int key_lo;
    bf16* o; size_t ostride;
    unsigned char* o8;
    float* lse; int lse_stride;
    const float* bias;
};
#define ATT_WAIT0() asm volatile("s_waitcnt vmcnt(0) lgkmcnt(0)" ::: "memory")
template <int OFF> __device__ __forceinline__ s16x4 att_tr_read(unsigned vb) { s16x4 r; asm volatile("ds_read_b64_tr_b16 %0, %1 offset:%2" : "=&v"(r) : "v"(vb), "i"(OFF) : "memory"); return r; }
template <int D, int S, int DB0> __device__ __forceinline__ void att_pv4(f32x4 (&oacc)[D / 16], const unsigned (&vb)[D / 16], const bf16x8 p) {
    constexpr int HIOFF = (D == 256 && S >= 4) ? 65536 : 0, OFF0 = (32 * S) * (2 * D) - HIOFF, OFF1 = OFF0 + 16 * (2 * D);
    const s16x4 a0 = att_tr_read<OFF0>(vb[DB0 + 0] + HIOFF), a1 = att_tr_read<OFF1>(vb[DB0 + 0] + HIOFF), b0 = att_tr_read<OFF0>(vb[DB0 + 1] + HIOFF), b1 = att_tr_read<OFF1>(vb[DB0 + 1] + HIOFF);
    const s16x4 c0 = att_tr_read<OFF0>(vb[DB0 + 2] + HIOFF), c1 = att_tr_read<OFF1>(vb[DB0 + 2] + HIOFF), d0 = att_tr_read<OFF0>(vb[DB0 + 3] + HIOFF), d1 = att_tr_read<OFF1>(vb[DB0 + 3] + HIOFF);
    asm volatile("s_waitcnt lgkmcnt(0)" ::: "memory"); __builtin_amdgcn_sched_barrier(0);
    oacc[DB0 + 0] = __builtin_amdgcn_mfma_f32_16x16x32_bf16(__builtin_shufflevector(a0, a1, 0, 1, 2, 3, 4, 5, 6, 7), p, oacc[DB0 + 0], 0, 0, 0);
    oacc[DB0 + 1] = __builtin_amdgcn_mfma_f32_16x16x32_bf16(__builtin_shufflevector(b0, b1, 0, 1, 2, 3, 4, 5, 6, 7), p, oacc[DB0 + 1], 0, 0, 0);
    oacc[DB0 + 2] = __builtin_amdgcn_mfma_f32_16x16x32_bf16(__builtin_shufflevector(c0, c1, 0, 1, 2, 3, 4, 5, 6, 7), p, oacc[DB0 + 2], 0, 0, 0);
    oacc[DB0 + 3] = __builtin_amdgcn_mfma_f32_16x16x32_bf16(__builtin_shufflevector(d0, d1, 0, 1, 2, 3, 4, 5, 6, 7), p, oacc[DB0 + 3], 0, 0, 0);
}
template <int D, int S> __device__ __forceinline__ void att_pv_step(f32x4 (&oacc)[D / 16], const unsigned (&vb)[D / 16], const bf16x8 p) {
    att_pv4<D, S, 0>(oacc, vb, p); att_pv4<D, S, 4>(oacc, vb, p);
    if constexpr (D == 256) { att_pv4<D, S, 8>(oacc, vb, p); att_pv4<D, S, 12>(oacc, vb, p); }
}
#define ATT_BAR() do { asm volatile("" ::: "memory"); __builtin_amdgcn_s_barrier(); asm volatile("" ::: "memory"); } while (0)
template <int D, bool DIL, class Maker>
__device__ __forceinline__ void attn_run(LAS unsigned char* lds, const Maker& mk, int first, int stride, int nitems, const int w  ) {
    const int lane = lane_id(), tid = w * 64 + lane;
    constexpr int NDC = D / 64, NKB = 2 * NDC, NV = D / 16, CPR = D / 8, RPB = 64 / CPR;
    constexpr int KOFF = 0, VOFF = (D == 128) ? 65536 : 0, BTOFF = 131072;
    if (first >= nitems) return;
    const int g = lane >> 4, c = lane & 15;
    LAS float* bt = (LAS float*)(lds + BTOFF);
    int Rk[2], Ck[2];
#pragma unroll
    for (int i = 0; i < 2; ++i) pg8::stage_rc(tid * 16 + i * 8192, Rk[i], Ck[i]);
    const int vrow = lane / CPR, vpos = lane % CPR;
    const int q4 = c >> 2, p4 = c & 3, sw3 = 4 * (g & 1) + q4;
    const unsigned vlane = VOFF + (4 * g + q4) * (2 * D) + 8 * (p4 & 1) + 16 * (p4 >> 1);
    const unsigned klane = KOFF + pg8::lds_byte(c, 8 * g);
    const unsigned ldsbase = (unsigned)(size_t)lds;
    bf16x8 qf[D / 32];
    f32x4 sacc[16];
    f32x4 oacc[D / 16];
    bf16x8 pf[8];
    float rl = 1.f, rm = 0.f;
#define ATT_ISSUE_K(it) do { int wv = w; asm volatile("" : "+s"(wv)); _Pragma("unroll") for (int hb = 0; hb < NKB; ++hb) { _Pragma("unroll") for (int i = 0; i < 2; ++i) { int row = (hb / NDC) * 128 + Rk[i]; row = row < (it).key_lo ? (it).key_lo : row; \
        __builtin_amdgcn_global_load_lds((const unsigned*)((it).k + (size_t)row * (it).kstride + (hb % NDC) * 64 + Ck[i]), (LAS unsigned*)(lds + KOFF + hb * 16384 + i * 8192 + wv * 1024), 16, 0, 0); } } } while (0)
#define ATT_ISSUE_V(it) do { int wv = w; asm volatile("" : "+s"(wv)); _Pragma("unroll") for (int j = 0; j < NV; ++j) { const int row = (j * 8 + wv) * RPB + vrow; const int rowc = row < (it).key_lo ? (it).key_lo : row; const int ch = vpos ^ ((row & 7) << 1); \
        __builtin_amdgcn_global_load_lds((const unsigned*)((it).v + (size_t)rowc * (it).kstride + 8 * ch), (LAS unsigned*)(lds + VOFF + (j * 8 + wv) * 1024), 16, 0, 0); } } while (0)
#define ATT_LOAD_Q(it) do { const bf16* qp = (it).q + (size_t)(16 * w + c) * (it).qstride + 8 * g; _Pragma("unroll") for (int s = 0; s < D / 32; ++s) qf[s] = *(const GAS bf16x8*)(qp + 32 * s); } while (0)
#define ATT_S_SOFTMAX(it) do { int wv = w; asm volatile("" : "+s"(wv)); \
    const int kb_lo = DIL ? (wv > ((it).key_lo >> 4) ? wv : ((it).key_lo >> 4)) : 0, kb_hi = DIL ? wv + 8 : 15; \
    _Pragma("unroll") for (int kb = 0; kb < 16; ++kb) sacc[kb] = (f32x4){0.f, 0.f, 0.f, 0.f}; \
    _Pragma("unroll") for (int kb = 0; kb < 16; ++kb) { if (kb >= kb_lo && kb <= kb_hi) { \
        _Pragma("unroll") for (int s = 0; s < D / 32; ++s) { \
            const bf16x8 kf = *(const LAS bf16x8*)(lds + klane + ((kb >> 3) * NDC + (s >> 1)) * 16384 + ((kb & 7) * 2 + (s & 1)) * 1024); \
            sacc[kb] = __builtin_amdgcn_mfma_f32_16x16x32_bf16(kf, qf[s], sacc[kb], 0, 0, 0); } } } \
    const float scale = DIL ? 0.08838834764831845f : 0.0625f; int ql = 16 * wv + c; asm volatile("" : "+v"(ql)); float mx = -3.0e38f; \
    _Pragma("unroll") for (int kb = 0; kb < 16; ++kb) { _Pragma("unroll") for (int r = 0; r < 4; ++r) { float lg; \
        if (DIL) { const int kl = 16 * kb + 4 * g + r, delta = ql + 128 - kl; const bool ok = (kb >= kb_lo) && (kb <= kb_hi) && delta >= 0 && delta <= 128 && kl >= (it).key_lo; \
            const int di = delta < 0 ? 0 : (delta > 128 ? 128 : delta); lg = ok ? sacc[kb][r] * scale + bt[di] : -3.0e38f; } \
        else lg = sacc[kb][r] * scale; \
        sacc[kb][r] = lg; mx = fmaxf(mx, lg); } } \
    mx = fmaxf(mx, __shfl_xor(mx, 16)); mx = fmaxf(mx, __shfl_xor(mx, 32)); float sum = 0.f; \
    _Pragma("unroll") for (int kb = 0; kb < 16; ++kb) { _Pragma("unroll") for (int r = 0; r < 4; ++r) { const float lg = sacc[kb][r]; const float p = lg > -1.0e38f ? __expf(lg - mx) : 0.f; sacc[kb][r] = p; sum += p; } } \
    sum += __shfl_xor(sum, 16); sum += __shfl_xor(sum, 32); rl = sum; rm = mx; \
    _Pragma("unroll") for (int s = 0; s < 8; ++s) { v4u pw; pw.x = pk2(sacc[2 * s][0], sacc[2 * s][1]); pw.y = pk2(sacc[2 * s][2], sacc[2 * s][3]); pw.z = pk2(sacc[2 * s + 1][0], sacc[2 * s + 1][1]); pw.w = pk2(sacc[2 * s + 1][2], sacc[2 * s + 1][3]); \
        pf[s] = __builtin_bit_cast(bf16x8, pw); } } while (0)
#define ATT_PV_STORE(it) do { int wv = w; asm volatile("" : "+s"(wv)); \
    const int kb_lo = DIL ? (wv > ((it).key_lo >> 4) ? wv : ((it).key_lo >> 4)) : 0, kb_hi = DIL ? wv + 8 : 15; \
    _Pragma("unroll") for (int i = 0; i < D / 16; ++i) oacc[i] = (f32x4){0.f, 0.f, 0.f, 0.f}; \
    unsigned vb[D / 16]; _Pragma("unroll") for (int db = 0; db < D / 16; ++db) vb[db] = ldsbase + vlane + 32 * (db ^ sw3); \
    if (1 >= kb_lo && 0 <= kb_hi) att_pv_step<D, 0>(oacc, vb, pf[0]); \
    if (3 >= kb_lo && 2 <= kb_hi) att_pv_step<D, 1>(oacc, vb, pf[1]); \
    if (5 >= kb_lo && 4 <= kb_hi) att_pv_step<D, 2>(oacc, vb, pf[2]); \
    if (7 >= kb_lo && 6 <= kb_hi) att_pv_step<D, 3>(oacc, vb, pf[3]); \
    if (9 >= kb_lo && 8 <= kb_hi) att_pv_step<D, 4>(oacc, vb, pf[4]); \
    if (11 >= kb_lo && 10 <= kb_hi) att_pv_step<D, 5>(oacc, vb, pf[5]); \
    if (13 >= kb_lo && 12 <= kb_hi) att_pv_step<D, 6>(oacc, vb, pf[6]); \
    if (15 >= kb_lo && 14 <= kb_hi) att_pv_step<D, 7>(oacc, vb, pf[7]); \
    const float inv = 1.0f / rl; bf16* op = (it).o + (size_t)(16 * w + c) * (it).ostride + 4 * g; \
    if ((it).o8) { const float inv16 = inv * 16.0f; unsigned char* op8 = (it).o8 + (size_t)(16 * w + c) * (it).ostride + 4 * g; \
        _Pragma("unroll") for (int db = 0; db < D / 16; ++db) { int p = __builtin_amdgcn_cvt_pk_fp8_f32(oacc[db][0] * inv16, oacc[db][1] * inv16, 0, false); p = __builtin_amdgcn_cvt_pk_fp8_f32(oacc[db][2] * inv16, oacc[db][3] * inv16, p, true); *(GAS int*)(op8 + 16 * db) = p; } } \
    else { _Pragma("unroll") for (int db = 0; db < D / 16; ++db) { v2u o2; o2.x = pk2(oacc[db][0] * inv, oacc[db][1] * inv); o2.y = pk2(oacc[db][2] * inv, oacc[db][3] * inv); *(GAS v2u*)(op + 16 * db) = o2; } } \
    if (DIL) { if (g == 0) (it).lse[(size_t)(16 * w + c) * (it).lse_stride] = rm + __logf(rl); } } while (0)

#define ATT_QFENCE() do { _Pragma("unroll") for (int s = 0; s < D / 32; ++s) asm volatile("" :: "v"(qf[s])); } while (0)
#define ATT_ITEM(idv) ([&]() { int _i = (idv); asm volatile("" : "+s"(_i)); return mk(_i); }())
    if constexpr (D == 128) {
        int id = first;
        { const AttnItem<D> it = ATT_ITEM(id); ATT_ISSUE_K(it); ATT_LOAD_Q(it); }
        for (;;) {
            { const AttnItem<D> it = ATT_ITEM(id);
              if (DIL) { if (tid < 129) bt[tid] = it.bias[tid]; }
              ATT_WAIT0(); ATT_QFENCE(); ATT_BAR();
              ATT_ISSUE_V(it); }
            { const AttnItem<D> it = ATT_ITEM(id); ATT_S_SOFTMAX(it); }
            ATT_WAIT0(); ATT_BAR();
            const int nid = id + stride; const bool has_next = nid < nitems;
            if (has_next) { const AttnItem<D> it = ATT_ITEM(nid); ATT_ISSUE_K(it); ATT_LOAD_Q(it); }
            { const AttnItem<D> it = ATT_ITEM(id); ATT_PV_STORE(it); }
            if (!has_next) break;
            id = nid;
        }
    } else {
        for (int id = first; id < nitems; id += stride) {
            { const AttnItem<D> it = ATT_ITEM(id); ATT_ISSUE_K(it); ATT_LOAD_Q(it); }
            ATT_WAIT0(); ATT_QFENCE(); ATT_BAR();
            { const AttnItem<D> it = ATT_ITEM(id); ATT_S_SOFTMAX(it); }
            ATT_WAIT0(); ATT_BAR();
            { const AttnItem<D> it = ATT_ITEM(id); ATT_ISSUE_V(it); }
            ATT_WAIT0(); ATT_BAR();
            { const AttnItem<D> it = ATT_ITEM(id); ATT_PV_STORE(it); }
            ATT_WAIT0(); ATT_BAR();
        }
    }
#undef ATT_ITEM
#undef ATT_QFENCE
    ATT_WAIT0(); ATT_BAR();
#undef ATT_ISSUE_K
#undef ATT_ISSUE_V
#undef ATT_LOAD_Q
#undef ATT_S_SOFTMAX
#undef ATT_PV_STORE
}

__device__ __forceinline__ void pool_phase(Frame& F, const bf16* U, bf16* POOLED) {
    const int lane = lane_id();
    const int gw = F.vcu * NWAVES + F.wave, NGW = F.G * NWAVES;
    constexpr int NTC = SEQ / 64, NCC = POOLW / 512, NIT = BATCH * NTC * NCC;
    for (int itx = gw; itx < NIT; itx += NGW) {
        const int cc = itx % NCC, tc = (itx / NCC) % NTC, b = itx / (NCC * NTC);
        const int col = 512 * cc + 8 * lane, w = 2 << (col / POOLG);
        const int t0 = 64 * tc, ts = t0 >= 16 ? t0 - 16 : 0;
        const bf16* ub = U + (size_t)b * SEQ * DM + col;
        bf16* pb = POOLED + (size_t)b * SEQ * DM + col;
        float S[8];
#pragma unroll
        for (int j = 0; j < 8; ++j) S[j] = 0.f;
#pragma unroll 8
        for (int t = ts; t < t0 + 64; ++t) {
            const v4u cur = *(const GAS v4u*)(ub + (size_t)t * DM);
            const int to = (t - w >= ts) ? t - w : t; const float sg = (t - w >= ts) ? 1.f : 0.f;
            const v4u old = *(const GAS v4u*)(ub + (size_t)to * DM);
            float cv[8] = {bflo(cur.x), bfhi(cur.x), bflo(cur.y), bfhi(cur.y), bflo(cur.z), bfhi(cur.z), bflo(cur.w), bfhi(cur.w)};
            float ov[8] = {bflo(old.x), bfhi(old.x), bflo(old.y), bfhi(old.y), bflo(old.z), bfhi(old.z), bflo(old.w), bfhi(old.w)};
#pragma unroll
            for (int j = 0; j < 8; ++j) S[j] += cv[j] - sg * ov[j];
            if (t >= t0) { const float ic = 1.0f / (float)((t + 1) < w ? (t + 1) : w); v4u o;
                o.x = pk2(S[0] * ic - cv[0], S[1] * ic - cv[1]); o.y = pk2(S[2] * ic - cv[2], S[3] * ic - cv[3]); o.z = pk2(S[4] * ic - cv[4], S[5] * ic - cv[5]); o.w = pk2(S[6] * ic - cv[6], S[7] * ic - cv[7]);
                *(GAS v4u*)(pb + (size_t)t * DM) = o; }
        }
    }
}
__device__ __forceinline__ void merge_phase(Frame& F, const bf16* OG, const float* LSE, unsigned char* CAT2) {
    const int gw = F.vcu * NWAVES + F.wave, NGW = F.G * NWAVES;
    const int lane = lane_id(), h = lane >> 3, col = h * 128 + 16 * (lane & 7);
    for (int row = gw; row < M; row += NGW) {
        const float* lp = LSE + (size_t)row * 24 + h * 3;
        const float l0 = lp[0], l1 = lp[1], l2 = lp[2];
        const float mx = fmaxf(l0, fmaxf(l1, l2));
        float w0 = __expf(l0 - mx), w1 = __expf(l1 - mx), w2 = __expf(l2 - mx); const float inv = 1.0f / (w0 + w1 + w2); w0 *= inv; w1 *= inv; w2 *= inv;
        float acc[16];
#pragma unroll
        for (int j = 0; j < 16; ++j) acc[j] = 0.f;
#pragma unroll
        for (int g = 0; g < 3; ++g) { const float wg = g == 0 ? w0 : (g == 1 ? w1 : w2); const bf16* src = OG + (size_t)g * M * 1024 + (size_t)row * 1024 + col;
#pragma unroll
            for (int hh = 0; hh < 2; ++hh) { const v4u x = *(const GAS v4u*)(src + 8 * hh);
                acc[8 * hh + 0] += wg * bflo(x.x); acc[8 * hh + 1] += wg * bfhi(x.x); acc[8 * hh + 2] += wg * bflo(x.y); acc[8 * hh + 3] += wg * bfhi(x.y);
                acc[8 * hh + 4] += wg * bflo(x.z); acc[8 * hh + 5] += wg * bfhi(x.z); acc[8 * hh + 6] += wg * bflo(x.w); acc[8 * hh + 7] += wg * bfhi(x.w); } }
        v4u o;
        { int p = __builtin_amdgcn_cvt_pk_fp8_f32(acc[0] * 16.f, acc[1] * 16.f, 0, false); p = __builtin_amdgcn_cvt_pk_fp8_f32(acc[2] * 16.f, acc[3] * 16.f, p, true); o.x = (unsigned)p; }
        { int p = __builtin_amdgcn_cvt_pk_fp8_f32(acc[4] * 16.f, acc[5] * 16.f, 0, false); p = __builtin_amdgcn_cvt_pk_fp8_f32(acc[6] * 16.f, acc[7] * 16.f, p, true); o.y = (unsigned)p; }
        { int p = __builtin_amdgcn_cvt_pk_fp8_f32(acc[8] * 16.f, acc[9] * 16.f, 0, false); p = __builtin_amdgcn_cvt_pk_fp8_f32(acc[10] * 16.f, acc[11] * 16.f, p, true); o.z = (unsigned)p; }
        { int p = __builtin_amdgcn_cvt_pk_fp8_f32(acc[12] * 16.f, acc[13] * 16.f, 0, false); p = __builtin_amdgcn_cvt_pk_fp8_f32(acc[14] * 16.f, acc[15] * 16.f, p, true); o.w = (unsigned)p; }
        *(GAS v4u*)(CAT2 + (size_t)row * 2048 + col) = o;
    }
}
__device__ __forceinline__ void w2q_colsum_phase(Frame& F, const unsigned char* W2Q, int* CS) {
    const int gw = F.vcu * NWAVES + F.wave, NGW = F.G * NWAVES, lane = lane_id();
    for (int n = gw; n < DM; n += NGW) {
        const GAS v4u* p = (const GAS v4u*)(W2Q + (size_t)n * DFF) + lane;
        v4u x[16];
#pragma unroll
        for (int j = 0; j < 16; ++j) x[j] = p[64 * j];
        int s = 0;
#define W2Q_BSUM(u) { const int w = (int)(u); s += ((w << 24) >> 24) + ((w << 16) >> 24) + ((w << 8) >> 24) + (w >> 24); }
#pragma unroll
        for (int j = 0; j < 16; ++j) { W2Q_BSUM(x[j].x) W2Q_BSUM(x[j].y) W2Q_BSUM(x[j].z) W2Q_BSUM(x[j].w) }
#undef W2Q_BSUM
#pragma unroll
        for (int o = 1; o < 64; o <<= 1) s += __shfl_xor(s, o);
        if (lane == 0) CS[n] = 128 * s;
    }
}
__device__ __forceinline__ void final_norm_phase(Frame& F, const bf16* XB, float* out, const float* gain, const int* evcnt, const int* ev, const float* W2f) {
    const int gw = F.vcu * NWAVES + F.wave, NGW = F.G * NWAVES, lane = lane_id();
    for (int row = gw; row < M; row += NGW) {
        const GAS v4u* xr = (const GAS v4u*)(XB + (size_t)row * DM) + lane; GAS f32x4* orow = (GAS f32x4*)(out + (size_t)row * DM) + 2 * lane; const GAS f32x4* gr = (const GAS f32x4*)gain + 2 * lane;
        v4u x[8];
#pragma unroll
        for (int j = 0; j < 8; ++j) x[j] = xr[64 * j];
        int cnt = __builtin_amdgcn_readfirstlane(evcnt[row]); cnt = cnt < pg8::EV_MAX ? cnt : pg8::EV_MAX;
        f32x4 o0[8], o1[8];
#pragma unroll
        for (int j = 0; j < 8; ++j) { o0[j] = (f32x4){bflo(x[j].x), bfhi(x[j].x), bflo(x[j].y), bfhi(x[j].y)}; o1[j] = (f32x4){bflo(x[j].z), bfhi(x[j].z), bflo(x[j].w), bfhi(x[j].w)}; }
        if (cnt > 0) {
            const int ek = lane < cnt ? ev[((size_t)row * pg8::EV_MAX + lane) * 2] : 0x7fffffff; const float ee = lane < cnt ? __builtin_bit_cast(float, ev[((size_t)row * pg8::EV_MAX + lane) * 2 + 1]) : 0.f;
            int rank = 0;
#pragma unroll
            for (int j = 0; j < pg8::EV_MAX; ++j) rank += (__shfl(ek, j) < ek) ? 1 : 0;
            for (int a = 0; a < cnt; ++a) {
                const unsigned long long mask = __ballot(lane < cnt && rank == a); const int src = __builtin_ctzll(mask);
                const int k = __shfl(ek, src); const float e = __shfl(ee, src);
                const GAS f32x4* wr = (const GAS f32x4*)(W2f + (size_t)k * DM) + 2 * lane;
#pragma unroll
                for (int j = 0; j < 8; ++j) { const f32x4 w0 = wr[128 * j], w1 = wr[128 * j + 1]; o0[j] += w0 * e; o1[j] += w1 * e; }
            }
        }
        float s = 0.f;
#pragma unroll
        for (int j = 0; j < 8; ++j) s += (o0[j].x * o0[j].x + o0[j].y * o0[j].y) + (o0[j].z * o0[j].z + o0[j].w * o0[j].w) + (o1[j].x * o1[j].x + o1[j].y * o1[j].y) + (o1[j].z * o1[j].z + o1[j].w * o1[j].w);
        s = wave_sum(s);
        const float r = __builtin_amdgcn_rsqf(s * (1.0f / 4096.0f) + pg8::RMS_EPS);
#pragma unroll
        for (int j = 0; j < 8; ++j) { const f32x4 g0 = gr[128 * j], g1 = gr[128 * j + 1]; orow[128 * j] = o0[j] * r * g0; orow[128 * j + 1] = o1[j] * r * g1; }
    }
}

struct MemMaker { const bf16* Qsrc; int ldq, qcol0; const bf16* MKV; int l; bf16* Odst; int ldo, ocol0; unsigned char* Odst8;
    __device__ __forceinline__ AttnItem<256> operator()(int id) const {
        const int qt = id % (SEQ / 128), h = (id / (SEQ / 128)) % 4, b = id / (4 * (SEQ / 128));
        AttnItem<256> it;
        it.q = Qsrc + (size_t)(b * SEQ + 128 * qt) * ldq + qcol0 + h * 256; it.qstride = (size_t)ldq;
        it.k = MKV + (size_t)(b * MEMLEN) * DM + l * 2048 + h * 256; it.v = it.k + 1024; it.kstride = DM; it.key_lo = 0;
        it.o = Odst + (size_t)(b * SEQ + 128 * qt) * ldo + ocol0 + h * 256; it.ostride = (size_t)ldo; it.lse = nullptr; it.lse_stride = 0; it.bias = nullptr;
        it.o8 = Odst8 ? Odst8 + (size_t)(b * SEQ + 128 * qt) * ldo + ocol0 + h * 256 : nullptr;
        return it; } };
__device__ __forceinline__ void memattn_phase(Frame& F, const bf16* Qsrc, int ldq, int qcol0, const bf16* MKV, int l, bf16* Odst, int ldo, int ocol0, unsigned char* Odst8) {
    const MemMaker mk{Qsrc, ldq, qcol0, MKV, l, Odst, ldo, ocol0, Odst8};
    attn_run<256, false>(F.lds + RING_OFF, mk, F.vcu, F.G, BATCH * 4 * (SEQ / 128), F.wave);
}
struct DilMaker { const bf16* KVU; bf16* OG; float* LSE; const float* BT;
    __device__ __forceinline__ AttnItem<128> operator()(int id) const {
        const int j = id & 15, g = (id >> 4) % 3, h = ((id >> 4) / 3) & 7, b = (id >> 4) / 24;
        const int dil = g == 0 ? 1 : (g == 1 ? 4 : 16), r = g == 0 ? 0 : (g == 1 ? (j >> 2) : j), n = g == 0 ? j : (g == 1 ? (j & 3) : 0);
        AttnItem<128> it;
        const size_t rs = (size_t)dil * KVUW;
        const long row_q0 = (long)b * SEQ + (long)(128 * n) * dil + r;
        it.q = KVU + (size_t)row_q0 * KVUW + KVW + g * 1024 + h * 128; it.qstride = rs;
        const bf16* kq0 = KVU + (size_t)row_q0 * KVUW + g * 1024 + h * 128;
        it.k = kq0 - 128 * rs; it.v = it.k + 3072; it.kstride = rs; it.key_lo = n == 0 ? 128 : 0;
        it.o = OG + (size_t)g * M * 1024 + (size_t)row_q0 * 1024 + h * 128; it.ostride = (size_t)dil * 1024; it.o8 = nullptr;
        it.lse = LSE + (size_t)row_q0 * 24 + h * 3 + g; it.lse_stride = dil * 24; it.bias = BT + (g * 8 + h) * 129;
        return it; } };
__device__ __forceinline__ void dilattn_phase(Frame& F, const bf16* KVU, bf16* OG, float* LSE, const float* BT) {
    const DilMaker mk{KVU, OG, LSE, BT};
    attn_run<128, true>(F.lds + RING_OFF, mk, F.vcu, F.G, BATCH * 8 * 3 * 16, F.wave);
}

struct Args { const float* in[19]; float* out; unsigned char* ws; int ph_lo, ph_hi, li, pad; };
constexpr int N_STEPS = 14;
typedef const Args __attribute__((address_space(4))) CArgs;
__device__ __forceinline__ CArgs* kargs() { CArgs* p = (CArgs*)__builtin_amdgcn_kernarg_segment_ptr(); asm volatile("" : "+s"(p)); return p; }
#ifndef MK_ONLY
#define MK_ONLY -1
#endif
#define STEP_ON(k) (MK_ONLY < 0 || MK_ONLY == (k))

template <int L> __device__ __forceinline__ void step_inproj(Frame& F) {
    CArgs* ap = kargs(); unsigned char* ws = ap->ws;
    if constexpr (L == 0) {
        pg8::Gemm g; g.A = (const bf16*)(ws + WS_XB); g.Bt = (const bf16*)(ws + WS_WAIN); g.M = M; g.N = DM; g.K = DM; g.lda = DM; g.ldb = DM; g.npg = 0; g.a_gstride = 0;
        pg8::StaticOrder S; S.init(g.M, g.N, F.G, (int)blockIdx.x);
        pg8::EpiScaleBf16<0> E{nullptr, nullptr, (bf16*)(ws + WS_U), DM, (const pg8::ssq_t*)(ws + WS_SSQ0), 1.0f};
        pg8::gemm_phase<pg8::EpiScaleBf16<0>, pg8::StaticOrder, PG8_ALIGN, PG8_SP2>(F.lds + RING_OFF, g, S, E, F.wave);
    } else {
        pg8::Gemm g; g.A = (const bf16*)(ws + WS_XB8); g.Bt = (const bf16*)(ws + WS_WKVB); g.M = M; g.N = KVUW; g.K = DM / 2; g.lda = DM / 2; g.ldb = DM / 2; g.npg = 0; g.a_gstride = 0;
        pg8::StaticOrder S; S.init(g.M, g.N, F.G, (int)blockIdx.x);
        pg8::EpiScaleBf16<0, true> E{nullptr, nullptr, (bf16*)(ws + WS_KVU), KVUW, (const pg8::ssq_t*)(ws + WS_CTL + CTL_SS) + 1 * M, pg8::X2_RMS_RATIO / (pg8::I8_SA * pg8::I8_SW), (const pg8::ssq_t*)(ws + WS_CTL + CTL_SS) + 0 * M};
        pg8::gemm_phase<pg8::EpiScaleBf16<0, true>, pg8::StaticOrder, PG8_ALIGN, PG8_SP2, false, true>(F.lds + RING_OFF, g, S, E, F.wave);
    }
    const int Gh = F.G / 2;
    if (L == 0 && (int)blockIdx.x < Gh) {
        pg8::Gemm g; g.A = (const bf16*)(ws + WS_MEMB); g.Bt = (const bf16*)(ws + WS_WMEMKV); g.M = MMEM; g.N = DM; g.K = DM; g.lda = DM; g.ldb = DM; g.npg = 0; g.a_gstride = 0;
        pg8::StaticOrder S; S.init(g.M, g.N, Gh, (int)blockIdx.x);
        pg8::EpiScaleBf16<0> E{nullptr, nullptr, (bf16*)(ws + WS_MKV), DM, (const pg8::ssq_t*)(ws + WS_SSQ0 + 131072), 1.0f};
        pg8::gemm_phase<pg8::EpiScaleBf16<0>, pg8::StaticOrder, PG8_ALIGN, PG8_SP2>(F.lds + RING_OFF, g, S, E, F.wave);
    }
    if (L == 0 && (int)blockIdx.x >= Gh) {
        pg8::Gemm g; g.A = (const bf16*)(ws + WS_WOUTP); g.Bt = (const bf16*)(ws + WS_WPG); g.M = DM; g.N = POOLW; g.K = POOLG; g.lda = POOLW; g.ldb = POOLG; g.npg = 3; g.a_gstride = POOLG * 2;
        pg8::StaticOrder S; S.init(g.M, g.N, F.G - Gh, (int)blockIdx.x - Gh);
        pg8::EpiScaleBf16<0> E{nullptr, nullptr, (bf16*)(ws + WS_WAOUT), DM, nullptr, 1.0f};
        pg8::gemm_phase<pg8::EpiScaleBf16<0>, pg8::StaticOrder, PG8_ALIGN, PG8_SP2>(F.lds + RING_OFF, g, S, E, F.wave);
    }
}
template <int L> __device__ __forceinline__ void step_mixer(Frame& F) {
    CArgs* ap = kargs(); unsigned char* ws = ap->ws;
    if (L == 0) {
        pool_phase(F, (const bf16*)(ws + WS_U), (bf16*)(ws + WS_CAT));
        memattn_phase(F, (const bf16*)(ws + WS_U), DM, POOLW, (const bf16*)(ws + WS_MKV), 0, (bf16*)(ws + WS_CAT), DM, POOLW, nullptr);
    } else {
        dilattn_phase(F, (const bf16*)(ws + WS_KVU), (bf16*)(ws + WS_OG), (float*)(ws + WS_LSE), (const float*)(ws + WS_SS0 + 131072));
        memattn_phase(F, (const bf16*)(ws + WS_KVU), KVUW, KVW + 3072, (const bf16*)(ws + WS_MKV), 1, nullptr, 2048, 1024, ws + WS_CAT2);
    }
}
template <int L> __device__ __forceinline__ void step_mix2(Frame& F) {
    CArgs* ap = kargs(); unsigned char* ws = ap->ws;
    if (L == 0) {
    } else {
        w2q_colsum_phase(F, ws + WS_W2 + (size_t)DM * DFF * 2, (int*)(ws + WS_SS0));
        merge_phase(F, (const bf16*)(ws + WS_OG), (const float*)(ws + WS_LSE), ws + WS_CAT2);
    }
}
template <int L> __device__ __forceinline__ void step_outproj(Frame& F) {
    CArgs* ap = kargs(); unsigned char* ws = ap->ws;
    pg8::StaticOrder S; S.init(M, DM, F.G, (int)blockIdx.x);
    if constexpr (L == 0) {
        pg8::Gemm g; g.A = (const bf16*)(ws + WS_CAT); g.Bt = (const bf16*)(ws + WS_WAOUT); g.M = M; g.N = DM; g.K = DM; g.lda = DM; g.ldb = DM; g.npg = 0; g.a_gstride = 0;
        pg8::EpiResid<2> E{(const bf16*)(ws + WS_XB), (bf16*)(ws + WS_XB), (pg8::ssq_t*)(ws + WS_CTL + CTL_SS) + 0 * M, ws + WS_XB8, 1.0f, (const pg8::ssq_t*)(ws + WS_SSQ0), pg8::I8_SA / pg8::X1_RMS_RATIO, nullptr};
        pg8::gemm_phase<pg8::EpiResid<2>, pg8::StaticOrder, PG8_ALIGN, PG8_SP2>(F.lds + RING_OFF, g, S, E, F.wave);
    } else {
        pg8::Gemm g; g.A = (const bf16*)(ws + WS_CAT2); g.Bt = (const bf16*)(ws + WS_WBOUT); g.M = M; g.N = DM; g.K = 1024; g.lda = 1024; g.ldb = 1024; g.npg = 0; g.a_gstride = 0;
        pg8::EpiResid<2> E{(const bf16*)(ws + WS_XB), (bf16*)(ws + WS_XB), (pg8::ssq_t*)(ws + WS_CTL + CTL_SS) + 2 * M, ws + WS_XB8, 1.0f / 1024.0f, (const pg8::ssq_t*)(ws + WS_CTL + CTL_SS) + 1 * M, pg8::I8_SA, nullptr};
        pg8::gemm_phase<pg8::EpiResid<2>, pg8::StaticOrder, PG8_ALIGN, PG8_SP2, true>(F.lds + RING_OFF, g, S, E, F.wave);
    }
}
template <int L> __device__ __forceinline__ void step_mlp1(Frame& F) {
    CArgs* ap = kargs(); unsigned char* ws = ap->ws;
    if constexpr (L == 0) {
    {
    pg8::Gemm g; g.A = (const bf16*)(ws + WS_XB8); g.Bt = (const bf16*)(ws + WS_W1); g.M = M; g.N = NQ0; g.K = DM / 2; g.lda = DM / 2; g.ldb = DM / 2; g.npg = 0; g.a_gstride = 0;
    pg8::StaticOrder S; S.init(g.M, g.N, F.G, (int)blockIdx.x);
    pg8::EpiScaleBf16<1, true> E{nullptr, nullptr, (bf16*)(ws + WS_HID), DFF, (const pg8::ssq_t*)(ws + WS_CTL + CTL_SS) + 0 * M, pg8::X1_RMS_RATIO / (pg8::I8_SA * pg8::I8_SW), (const pg8::ssq_t*)(ws + WS_SSQ0)};
    pg8::gemm_phase<pg8::EpiScaleBf16<1, true>, pg8::StaticOrder, PG8_ALIGN, PG8_SP2, false, true>(F.lds + RING_OFF, g, S, E, F.wave);
    }
    if constexpr (NQ0 < DFF) {
    pg8::Gemm g; g.A = (const bf16*)(ws + WS_XB); g.Bt = (const bf16*)(ws + WS_W1 + 64 * MiB); g.M = M; g.N = DFF - NQ0; g.K = DM; g.lda = DM; g.ldb = DM; g.npg = 0; g.a_gstride = 0;
    pg8::StaticOrder S; S.init(g.M, g.N, F.G, (int)blockIdx.x);
    pg8::EpiScaleBf16<1> E{nullptr, nullptr, (bf16*)(ws + WS_HID) + NQ0, DFF, (const pg8::ssq_t*)(ws + WS_CTL + CTL_SS) + 0 * M, 1.0f, nullptr};
    pg8::gemm_phase<pg8::EpiScaleBf16<1>, pg8::StaticOrder, PG8_ALIGN, PG8_SP2>(F.lds + RING_OFF, g, S, E, F.wave);
    }
    } else {
    pg8::Gemm g; g.A = (const bf16*)(ws + WS_XB8); g.Bt = (const bf16*)(ws + WS_W1) + (size_t)DFF * DM; g.M = M; g.N = DFF; g.K = DM / 2; g.lda = DM / 2; g.ldb = DM / 2; g.npg = 0; g.a_gstride = 0;
    pg8::StaticOrder S; S.init(g.M, g.N, F.G, (int)blockIdx.x);
    pg8::EpiScaleBf16<1, true, 1> E{(int*)(ws + WS_CTL + CTL_EVCNT), (int*)(ws + WS_EV), (bf16*)(ws + WS_HID), DFF, (const pg8::ssq_t*)(ws + WS_CTL + CTL_SS) + 2 * M, 1.0f / (pg8::I8_SA * pg8::I8_SW), (const pg8::ssq_t*)(ws + WS_CTL + CTL_SS) + 1 * M};
    pg8::gemm_phase<pg8::EpiScaleBf16<1, true, 1>, pg8::StaticOrder, PG8_ALIGN, PG8_SP2, false, true>(F.lds + RING_OFF, g, S, E, F.wave);
    }
}
template <int L> __device__ __forceinline__ void step_mlp2(Frame& F) {
    CArgs* ap = kargs(); unsigned char* ws = ap->ws;
    if constexpr (L == 0) {
    pg8::Gemm g; g.A = (const bf16*)(ws + WS_HID); g.Bt = (const bf16*)(ws + WS_W2); g.M = M; g.N = DM; g.K = DFF; g.lda = DFF; g.ldb = DFF; g.npg = 0; g.a_gstride = 0;
    pg8::StaticOrder S; S.init(g.M, g.N, F.G, (int)blockIdx.x);
    pg8::EpiResid<2> E{(const bf16*)(ws + WS_XB), (bf16*)(ws + WS_XB), (pg8::ssq_t*)(ws + WS_CTL + CTL_SS) + 1 * M, (unsigned char*)(ws + WS_XB8), 1.0f, (const pg8::ssq_t*)(ws + WS_CTL + CTL_SS) + 0 * M, pg8::I8_SA / pg8::X2_RMS_RATIO, nullptr};
    pg8::gemm_phase<pg8::EpiResid<2>, pg8::StaticOrder, PG8_ALIGN, PG8_SP2>(F.lds + RING_OFF, g, S, E, F.wave);
    } else {
    pg8::Gemm g; g.A = (const bf16*)(ws + WS_HID); g.Bt = (const bf16*)(ws + WS_W2) + (size_t)DM * DFF; g.M = M; g.N = DM; g.K = DFF / 2; g.lda = DFF / 2; g.ldb = DFF / 2; g.npg = 0; g.a_gstride = 0;
    pg8::StaticOrder S; S.init(g.M, g.N, F.G, (int)blockIdx.x);
    pg8::EpiResid<0, true> E{(const bf16*)(ws + WS_XB), (bf16*)(ws + WS_XB), (pg8::ssq_t*)(ws + WS_CTL + CTL_SS) + 3 * M, nullptr, pg8::HQ_R / (255.0f * pg8::I8_SW2), nullptr, 0.f, (const int*)(ws + WS_SS0)};
    pg8::gemm_phase<pg8::EpiResid<0, true>, pg8::StaticOrder, PG8_ALIGN, PG8_SP2, false, true>(F.lds + RING_OFF, g, S, E, F.wave);
    }
}

__global__ void __launch_bounds__(NWAVES * 64, 2) yoco_fwd(Args args) {
    extern __shared__ __attribute__((aligned(16))) unsigned char lds[];
    Frame F;
    F.lds = (LAS unsigned char*)lds;
    F.MISC = (volatile LAS unsigned*)(F.lds + MISC_OFF);
    F.wave = __builtin_amdgcn_readfirstlane((int)threadIdx.x >> 6);
    F.G = gridDim.x; { const int bx = blockIdx.x; F.vcu = (F.G % 8 == 0) ? (bx % 8) * (F.G / 8) + bx / 8 : bx; }
    F.ctl = (gu32*)(kargs()->ws + WS_CTL);
    for (int u = F.wave * 64 + lane_id(); u < (LDS_BYTES - LDSCTL_OFF) / 4; u += NWAVES * 64) ((LAS unsigned*)(F.lds + LDSCTL_OFF))[u] = 0u;
    __syncthreads();
    XcdBarrier bar; bar.bar = (unsigned*)(F.ctl + CW_BAR); bar.x = 0; bar.st = nullptr;
#define LEADER() (F.wave == 0 && lane_id() == 0)
    if (!MK_PER_PHASE) bar = xcd_barrier_post((unsigned*)(F.ctl + CW_BAR), F.MISC + 8, LEADER());
#define GRID_BAR() do { if (MK_PER_PHASE) { if (LEADER()) __hip_atomic_store(F.ctl + CW_TMO, 0xBADBA0u, RLX_AGENT); } else { xcd_barrier(bar, LEADER()); } } while (0)
#define LO (kargs()->ph_lo)
#define HI (kargs()->ph_hi)
#define IN(k) (STEP_ON(k) && LO <= (k) && (k) < HI)
#define SEAM(k) do { if (LO <= (k) && (k) + 1 < HI) GRID_BAR(); } while (0)

    if (IN(0)) { CArgs* ap = kargs(); Ptrs P;
        P.x = ap->in[0]; P.mem = ap->in[1]; P.a_norm = ap->in[2]; P.a_w_in = ap->in[3]; P.a_w_pg = ap->in[4]; P.a_scale = ap->in[5]; P.a_w_out = ap->in[6]; P.kv_norm = ap->in[7]; P.w_kv = ap->in[8];
        P.b_norm = ap->in[9]; P.b_w_in = ap->in[10]; P.b_w_out = ap->in[11]; P.mem_norm = ap->in[12]; P.w_mem_kv = ap->in[13]; P.mlp_norm = ap->in[14]; P.mlp_w1 = ap->in[15]; P.mlp_w2 = ap->in[16];
        P.rel_bias = ap->in[17]; P.final_norm = ap->in[18];
        p0_prologue(F, P, ap->ws); }
    SEAM(0);
    if (IN(1)) step_inproj<0>(F);
    SEAM(1);
    if (IN(2)) step_mixer<0>(F);
    SEAM(2);
    if (IN(4)) step_outproj<0>(F);
    SEAM(4);
    if (IN(5)) step_mlp1<0>(F);
    SEAM(5);
    if (IN(6)) step_mlp2<0>(F);
    SEAM(6);
    if (IN(7)) step_inproj<1>(F);
    SEAM(7);
    if (IN(8)) step_mixer<1>(F);
    SEAM(8);
    if (IN(9)) step_mix2<1>(F);
    SEAM(9);
    if (IN(10)) step_outproj<1>(F);
    SEAM(10);
    if (IN(11)) step_mlp1<1>(F);
    SEAM(11);
    if (IN(12)) step_mlp2<1>(F);
    SEAM(12);
    if (IN(13)) { CArgs* ap = kargs(); final_norm_phase(F, (const bf16*)(ap->ws + WS_XB), ap->out, ap->in[18], (const int*)(ap->ws + WS_CTL + CTL_EVCNT), (const int*)(ap->ws + WS_EV), ap->in[16] + (size_t)DFF * DM); }
#undef IN
#undef SEAM
}

extern "C" void kernel_launch(void* const* d_in, const int* in_sizes, int n_in, void* d_out, int out_size, void* d_ws, size_t ws_size, hipStream_t stream) {
    static int grid = 0;
    if (grid == 0) {
        if (n_in != 19 || in_sizes[0] != M * DM || out_size != M * DM || ws_size < WS_END) { fprintf(stderr, "kernel_launch: unexpected shapes (n_in %d, in0 %d, out %d, ws %zu); nothing launched\n", n_in, n_in > 0 ? in_sizes[0] : -1, out_size, ws_size); grid = -1; return; }
        int dev = 0, cus = 0, per_cu = 0;
        if (hipGetDevice(&dev) != hipSuccess || hipDeviceGetAttribute(&cus, hipDeviceAttributeMultiprocessorCount, dev) != hipSuccess) { fprintf(stderr, "kernel_launch: device query failed\n"); grid = -1; return; }
        if (hipFuncSetAttribute((const void*)yoco_fwd, hipFuncAttributeMaxDynamicSharedMemorySize, LDS_BYTES) != hipSuccess) { fprintf(stderr, "kernel_launch: hipFuncSetAttribute failed\n"); grid = -1; return; }
        if (hipOccupancyMaxActiveBlocksPerMultiprocessor(&per_cu, (const void*)yoco_fwd, NWAVES * 64, LDS_BYTES) != hipSuccess || per_cu < 1)
            fprintf(stderr, "kernel_launch: note: occupancy query reports %d workgroups per CU\n", per_cu);
        (void)hipGetLastError();
        grid = cus;
    }
    if (grid < 0) return;
    if (hipMemsetAsync((char*)d_ws + WS_CTL, 0, CTL_ZERO_BYTES, stream) != hipSuccess) { fprintf(stderr, "kernel_launch: memset failed\n"); return; }
    Args a{};
    for (int i = 0; i < 19; ++i) a.in[i] = (const float*)d_in[i];
    a.out = (float*)d_out; a.ws = (unsigned char*)d_ws;
#if MK_PER_PHASE
    for (int li = 0; li < N_STEPS; ++li) { a.ph_lo = li; a.ph_hi = li + 1; a.li = li;
        hipLaunchKernelGGL(yoco_fwd, dim3(grid), dim3(NWAVES * 64), LDS_BYTES, stream, a); }
#else
    a.ph_lo = 0; a.ph_hi = N_STEPS; a.li = 0;
    hipLaunchKernelGGL(yoco_fwd, dim3(grid), dim3(NWAVES * 64), LDS_BYTES, stream, a);
#endif
    const hipError_t le = hipPeekAtLastError();
    if (le != hipSuccess) fprintf(stderr, "kernel_launch: launch failed: %s\n", hipGetErrorName(le));
}
```

```cpp
#include <hip/hip_runtime.h>
#include <cstdio>
#include <cstdint>

#ifndef MK_PER_PHASE
#define MK_PER_PHASE 0
#endif

__device__ __forceinline__ int lane_id() { unsigned m = ~0u; asm volatile("" : "+s"(m)); return (int)__builtin_amdgcn_mbcnt_hi(m, __builtin_amdgcn_mbcnt_lo(m, 0u)); }
namespace pg8 {
#define PG8_LAS __attribute__((address_space(3)))
typedef unsigned short bf16_t;
typedef short bf16x8 __attribute__((ext_vector_type(8)));
typedef float f32x4 __attribute__((ext_vector_type(4)));
typedef unsigned u32x4 __attribute__((ext_vector_type(4)));
constexpr int BM = 256, BK = 64, HALF = 128, HTB = HALF * BK * 2  , STAGE_BYTES = 8 * HTB, NXCD = 8, WGM = 8;

__host__ __device__ __forceinline__ int lds_byte(int r, int c) { const int st = (r >> 4) * 2 + (c >> 5), rr = r & 15, cc = c & 31, ob = rr * 64 + cc * 2; return st * 1024 + (ob ^ (((ob >> 9) & 1) << 5)); }
__host__ __device__ __forceinline__ void stage_rc(int b, int& R, int& C) { const int st = b / 1024, sb = b % 1024, swz = sb ^ (((sb >> 9) & 1) << 5); R = (st >> 1) * 16 + swz / 64; C = (st & 1) * 32 + (swz % 64) / 2; }
__host__ __device__ __forceinline__ int perm32(int rho) { const int n = rho >> 4, i = rho & 15; return 8 * (i >> 2) + 4 * n + (i & 3); }

struct Unit { int pm, pn; };
struct Gemm { const bf16_t* A; const bf16_t* Bt; int M, N, K, lda, ldb, npg, a_gstride; };

struct StaticOrder {
    int nM, nN, nwg, G, c;
    __host__ __device__ void init(int M, int N, int G_, int c_) { nM = M / BM; nN = N / BM; nwg = nM * nN; G = G_; c = c_; }
    __host__ __device__ bool next(int i, Unit& u) const {
        const long L = (long)i * G + c; if (L >= nwg) return false;
        int wgid = (int)L; { const int q = nwg / NXCD, r = nwg % NXCD, xcd = wgid % NXCD, off = wgid / NXCD; wgid = (xcd < r ? xcd * (q + 1) : r * (q + 1) + (xcd - r) * q) + off; }
        const int nig = WGM * nN, gid = wgid / nig, fm = gid * WGM, gsz = (nM - fm) < WGM ? (nM - fm) : WGM;
        u.pm = fm + ((wgid % nig) % gsz); u.pn = (wgid % nig) / gsz; return true;
    }
    __device__ __forceinline__ void a_ready(const Unit&) const {}
    __device__ __forceinline__ void done(const Unit&) const {}
};

__device__ __forceinline__ unsigned cvt_pk_bf16(float lo, float hi) { unsigned r; asm volatile("v_cvt_pk_bf16_f32 %0, %1, %2" : "=v"(r) : "v"(lo), "v"(hi)); return r; }

constexpr float RMS_EPS = 1e-6f;
typedef unsigned long long ssq_t;
constexpr float SSQ_SCALE = 1048576.0f, SSQ_TO_MEAN = 1.0f / (1048576.0f * 4096.0f);
__device__ __forceinline__ ssq_t ssq_from(float s) { return (ssq_t)(s * SSQ_SCALE + 0.5f); }
__device__ __forceinline__ float rstd_of(ssq_t s) { return __builtin_amdgcn_rsqf((float)s * SSQ_TO_MEAN + RMS_EPS); }
typedef int i32x4 __attribute__((ext_vector_type(4)));
constexpr float I8_SW2 = 127.0f * 128.0f / 4.0f;
constexpr float I8_SW = 127.0f * 64.0f / 4.0f;
constexpr float I8_SA = 127.0f / 4.0f;
constexpr float X1_RMS_RATIO = 1.256f;
constexpr float X2_RMS_RATIO = 1.40f;
__device__ __forceinline__ float rms_of(ssq_t s) { return __builtin_sqrtf((float)s * SSQ_TO_MEAN + RMS_EPS); }
__device__ __forceinline__ unsigned q8(float v) { return (unsigned)(int)__builtin_rintf(__builtin_amdgcn_fmed3f(v, -127.0f, 127.0f)) & 255u; }
__device__ __forceinline__ unsigned pack_q8(float a, float b, float c, float d) { return q8(a) | (q8(b) << 8) | (q8(c) << 16) | (q8(d) << 24); }
constexpr int EV_MAX = 8;
constexpr float HQ_R = 17.0f;
template <int ACT, bool IACC = false, int OQ = 0> struct EpiScaleBf16 {
    static constexpr bool PERM = true, AFTER_DRAIN = false, CINIT = false;
    int* evcnt; int* ev;
    bf16_t* O; int ldc; const ssq_t* ss; float mul; const ssq_t* ssq;
    __device__ __forceinline__ void operator()(const f32x4 (&acc)[2][2][4][2], const Unit& u, int wr, int wc, int fr, int fq) const {
        const int row0 = u.pm * BM + wr * 64 + fr, col0 = u.pn * BM + wc * 32 + 8 * fq;
        float rs[2][4];
#pragma unroll
        for (int ai = 0; ai < 2; ++ai)
#pragma unroll
            for (int m = 0; m < 4; ++m) { rs[ai][m] = (ss ? rstd_of(ss[row0 + ai * HALF + m * 16]) : 1.0f) * mul;
                if constexpr (IACC) { if (ssq) rs[ai][m] *= rms_of(ssq[row0 + ai * HALF + m * 16]); } }
#pragma unroll
        for (int ai = 0; ai < 2; ++ai)
#pragma unroll
            for (int m = 0; m < 4; ++m) { bf16_t* rowp = O + (size_t)(row0 + ai * HALF + m * 16) * ldc + col0; const float r = rs[ai][m];
#pragma unroll
                for (int bj = 0; bj < 2; ++bj) { f32x4 v0, v1;
                    if constexpr (IACC) { const i32x4 i0 = __builtin_bit_cast(i32x4, acc[ai][bj][m][0]), i1 = __builtin_bit_cast(i32x4, acc[ai][bj][m][1]);
                        v0 = (f32x4){(float)i0[0], (float)i0[1], (float)i0[2], (float)i0[3]} * r; v1 = (f32x4){(float)i1[0], (float)i1[1], (float)i1[2], (float)i1[3]} * r; }
                    else { v0 = acc[ai][bj][m][0] * r; v1 = acc[ai][bj][m][1] * r; }
                    if (ACT == 1) {
#pragma unroll
                        for (int j = 0; j < 4; ++j) { const float a = fmaxf(v0[j], 0.f), b = fmaxf(v1[j], 0.f); v0[j] = a * a; v1[j] = b * b; } }
                    if constexpr (OQ == 1) { typedef unsigned v2u_t __attribute__((ext_vector_type(2))); constexpr float s = 255.0f / HQ_R;
#define PG8_HQ(v) ((unsigned)(int)__builtin_rintf(__builtin_fminf((v) * s, 255.0f)))
                        const unsigned q0 = (PG8_HQ(v0[0]) | (PG8_HQ(v0[1]) << 8) | (PG8_HQ(v0[2]) << 16) | (PG8_HQ(v0[3]) << 24)) ^ 0x80808080u;
                        const unsigned q1 = (PG8_HQ(v1[0]) | (PG8_HQ(v1[1]) << 8) | (PG8_HQ(v1[2]) << 16) | (PG8_HQ(v1[3]) << 24)) ^ 0x80808080u;
#undef PG8_HQ
                        *(v2u_t*)((unsigned char*)O + (size_t)(row0 + ai * HALF + m * 16) * ldc + col0 + bj * HALF) = (v2u_t){q0, q1};
                        const float vmx = fmaxf(fmaxf(fmaxf(v0[0], v0[1]), fmaxf(v0[2], v0[3])), fmaxf(fmaxf(v1[0], v1[1]), fmaxf(v1[2], v1[3])));
                        if (vmx > HQ_R) {
                            const int row = row0 + ai * HALF + m * 16;
#pragma unroll
                            for (int j = 0; j < 8; ++j) { const float v = j < 4 ? v0[j & 3] : v1[j & 3];
                                if (v > HQ_R) { const int idx = __hip_atomic_fetch_add(evcnt + row, 1, __ATOMIC_RELAXED, __HIP_MEMORY_SCOPE_AGENT);
                                    if (idx < EV_MAX) { typedef int v2i_t __attribute__((ext_vector_type(2))); *(v2i_t*)(ev + ((size_t)row * EV_MAX + idx) * 2) = (v2i_t){col0 + bj * HALF + j, __builtin_bit_cast(int, v - HQ_R)}; } } }
                        }
                    } else {
                    u32x4 w; w.x = cvt_pk_bf16(v0[0], v0[1]); w.y = cvt_pk_bf16(v0[2], v0[3]); w.z = cvt_pk_bf16(v1[0], v1[1]); w.w = cvt_pk_bf16(v1[2], v1[3]);
                    *(u32x4*)(rowp + bj * HALF) = w; } } }
    }
};
template <int XQ = 0, bool IACC = false> struct EpiResid {
    static constexpr bool PERM = true, AFTER_DRAIN = false, CINIT = IACC;
    const bf16_t* xin; bf16_t* xout; ssq_t* ss; unsigned char* x8; float mul; const ssq_t* qss; float qmul; const int* cs;
    __device__ __forceinline__ void init_acc(f32x4 (&acc)[2][2][4][2], const Unit& u, int wc, int fq) const {
#pragma unroll
        for (int bj = 0; bj < 2; ++bj)
#pragma unroll
            for (int n = 0; n < 2; ++n) { const i32x4 c = *(const i32x4*)(cs + u.pn * BM + bj * HALF + wc * 32 + 8 * fq + 4 * n);
#pragma unroll
                for (int ai = 0; ai < 2; ++ai)
#pragma unroll
                    for (int m = 0; m < 4; ++m) acc[ai][bj][m][n] = __builtin_bit_cast(f32x4, c); }
    }
    __device__ __forceinline__ void operator()(const f32x4 (&acc)[2][2][4][2], const Unit& u, int wr, int wc, int fr, int fq) const {
        const int row0 = u.pm * BM + wr * 64 + fr, col0 = u.pn * BM + wc * 32 + 8 * fq;
#pragma unroll
        for (int ai = 0; ai < 2; ++ai) {
            u32x4 xr[4][2];
#pragma unroll
            for (int m = 0; m < 4; ++m)
#pragma unroll
                for (int bj = 0; bj < 2; ++bj) xr[m][bj] = *(const u32x4*)(xin + (size_t)(row0 + ai * HALF + m * 16) * 4096 + col0 + bj * HALF);
#pragma unroll
            for (int m = 0; m < 4; ++m) { const int row = row0 + ai * HALF + m * 16; const size_t off = (size_t)row * 4096 + col0; float sq = 0.f;
                float qs = 0.f; if constexpr (XQ == 2) qs = rstd_of(qss[row]) * qmul;
#pragma unroll
                for (int bj = 0; bj < 2; ++bj) { const u32x4 x = xr[m][bj];
                    const f32x4 a0 = {__builtin_bit_cast(float, x.x << 16), __builtin_bit_cast(float, x.x & 0xffff0000u), __builtin_bit_cast(float, x.y << 16), __builtin_bit_cast(float, x.y & 0xffff0000u)};
                    const f32x4 a1 = {__builtin_bit_cast(float, x.z << 16), __builtin_bit_cast(float, x.z & 0xffff0000u), __builtin_bit_cast(float, x.w << 16), __builtin_bit_cast(float, x.w & 0xffff0000u)};
                    f32x4 c0, c1;
                    if constexpr (IACC) { const i32x4 i0 = __builtin_bit_cast(i32x4, acc[ai][bj][m][0]), i1 = __builtin_bit_cast(i32x4, acc[ai][bj][m][1]);
                        c0 = (f32x4){(float)i0[0], (float)i0[1], (float)i0[2], (float)i0[3]}; c1 = (f32x4){(float)i1[0], (float)i1[1], (float)i1[2], (float)i1[3]}; }
                    else { c0 = acc[ai][bj][m][0]; c1 = acc[ai][bj][m][1]; }
                    const f32x4 v0 = c0 * mul + a0, v1 = c1 * mul + a1;
                    u32x4 w; w.x = cvt_pk_bf16(v0[0], v0[1]); w.y = cvt_pk_bf16(v0[2], v0[3]); w.z = cvt_pk_bf16(v1[0], v1[1]); w.w = cvt_pk_bf16(v1[2], v1[3]); *(u32x4*)(xout + off + bj * HALF) = w;
                    if constexpr (XQ == 2) { typedef unsigned v2u_t __attribute__((ext_vector_type(2)));
                        *(v2u_t*)(x8 + off + bj * HALF) = (v2u_t){pack_q8(v0[0] * qs, v0[1] * qs, v0[2] * qs, v0[3] * qs), pack_q8(v1[0] * qs, v1[1] * qs, v1[2] * qs, v1[3] * qs)}; }
                    if constexpr (XQ == 1) { int p0 = __builtin_amdgcn_cvt_pk_fp8_f32(v0[0], v0[1], 0, false); p0 = __builtin_amdgcn_cvt_pk_fp8_f32(v0[2], v0[3], p0, true);
                        int p1 = __builtin_amdgcn_cvt_pk_fp8_f32(v1[0], v1[1], 0, false); p1 = __builtin_amdgcn_cvt_pk_fp8_f32(v1[2], v1[3], p1, true);
                        typedef int v2i_t __attribute__((ext_vector_type(2))); *(v2i_t*)(x8 + off + bj * HALF) = (v2i_t){p0, p1}; }
                    sq += (v0[0] * v0[0] + v0[1] * v0[1]) + (v0[2] * v0[2] + v0[3] * v0[3]) + (v1[0] * v1[0] + v1[1] * v1[1]) + (v1[2] * v1[2] + v1[3] * v1[3]); }
                sq += __shfl_xor(sq, 16); sq += __shfl_xor(sq, 32);
                if (fq == 0) __hip_atomic_fetch_add(ss + row, ssq_from(sq), __ATOMIC_RELAXED, __HIP_MEMORY_SCOPE_AGENT); }
            asm volatile("" ::: "memory");
        }
    }
};

typedef int v4i_t __attribute__((ext_vector_type(4)));
typedef int v8i_t __attribute__((ext_vector_type(8)));
__device__ __forceinline__ v8i_t cat8(const bf16x8 lo, const bf16x8 hi) { return __builtin_shufflevector(__builtin_bit_cast(v4i_t, lo), __builtin_bit_cast(v4i_t, hi), 0, 1, 2, 3, 4, 5, 6, 7); }
template <class Epi, class Sched, bool ALIGN_EPI = false, bool SP2 = false, bool F8 = false, bool I8 = false>
__device__ __forceinline__ void gemm_phase(PG8_LAS unsigned char* lds, const Gemm g, const Sched& S, const Epi& E, const int wid  ) {
    const int lane = lane_id(), tid = wid * 64 + lane, wr = wid >> 2, wc = wid & 3, fr = lane & 15, fq = lane >> 4;
    const int K = g.K, nt = K / BK;
    unsigned voffA[2], voffB[2];
#pragma unroll
    for (int i = 0; i < 2; ++i) { int R, C; stage_rc(tid * 16 + i * 8192, R, C); const int Rb = Epi::PERM ? ((R & ~31) + perm32(R & 31)) : R;
        voffA[i] = (unsigned)(R * g.lda + C) * 2u; voffB[i] = (unsigned)(Rb * g.ldb + C) * 2u; }
    const size_t kstep = (size_t)(BK * 2);
    const size_t hstepA = (size_t)HALF * g.lda * 2, hstepB = (size_t)HALF * g.ldb * 2;
    const size_t tstepA = 2 * hstepA, tstepB = 2 * hstepB;
    const unsigned ldsw = (unsigned)wid * 1024u;
    const int aoff = lds_byte(wr * 64 + fr, fq * 8), boff = lds_byte(wc * 32 + fr, fq * 8);
#define PG8_SA(b, h) (((b) * 2 + (h)) * HTB)
#define PG8_SB(b, h) ((4 + (b) * 2 + (h)) * HTB)
#define PG8_STAGE(bufoff, gbase, voff) do { _Pragma("unroll") for (int _i = 0; _i < 2; ++_i) \
        __builtin_amdgcn_global_load_lds((const unsigned*)((const char*)(gbase) + (voff)[_i]), (PG8_LAS unsigned*)(lds + (bufoff) + ldsw + _i * 8192), 16, 0, 0); } while (0)
#define PG8_LDA(dst, b, h) do { _Pragma("unroll") for (int m = 0; m < 4; ++m) { \
        if constexpr (F8) dst##8[m] = cat8(*(const PG8_LAS bf16x8*)(lds + PG8_SA(b, h) + aoff + m * 2048), *(const PG8_LAS bf16x8*)(lds + PG8_SA(b, h) + aoff + m * 2048 + 1024)); \
        else { _Pragma("unroll") for (int k = 0; k < 2; ++k) dst[m][k] = *(const PG8_LAS bf16x8*)(lds + PG8_SA(b, h) + aoff + m * 2048 + k * 1024); } } } while (0)
#define PG8_LDB(dst, b, h) do { _Pragma("unroll") for (int n = 0; n < 2; ++n) { \
        if constexpr (F8) dst##8[n] = cat8(*(const PG8_LAS bf16x8*)(lds + PG8_SB(b, h) + boff + n * 2048), *(const PG8_LAS bf16x8*)(lds + PG8_SB(b, h) + boff + n * 2048 + 1024)); \
        else { _Pragma("unroll") for (int k = 0; k < 2; ++k) dst[n][k] = *(const PG8_LAS bf16x8*)(lds + PG8_SB(b, h) + boff + n * 2048 + k * 1024); } } } while (0)
#define PG8_MMA(ai, bj, At, Bt) do { __builtin_amdgcn_s_setprio(1); \
        if constexpr (F8) { _Pragma("unroll") for (int m = 0; m < 4; ++m) _Pragma("unroll") for (int n = 0; n < 2; ++n) \
            asm volatile("v_mfma_scale_f32_16x16x128_f8f6f4 %0, %1, %2, %0, %3, %3 op_sel_hi:[0,0,0]" : "+v"(acc[ai][bj][m][n]) : "v"(Bt##8[n]), "v"(At##8[m]), "v"(one_scale)); } \
        else if constexpr (I8) { _Pragma("unroll") for (int m = 0; m < 4; ++m) _Pragma("unroll") for (int n = 0; n < 2; ++n) _Pragma("unroll") for (int k = 0; k < 2; ++k) \
            acc[ai][bj][m][n] = __builtin_bit_cast(f32x4, __builtin_amdgcn_mfma_i32_16x16x64_i8(__builtin_bit_cast(v4i_t, Bt[n][k]), __builtin_bit_cast(v4i_t, At[m][k]), __builtin_bit_cast(v4i_t, acc[ai][bj][m][n]), 0, 0, 0)); } \
        else { _Pragma("unroll") for (int m = 0; m < 4; ++m) _Pragma("unroll") for (int n = 0; n < 2; ++n) _Pragma("unroll") for (int k = 0; k < 2; ++k) \
            acc[ai][bj][m][n] = __builtin_amdgcn_mfma_f32_16x16x32_bf16(Bt[n][k], At[m][k], acc[ai][bj][m][n], 0, 0, 0); } \
        __builtin_amdgcn_s_setprio(0); } while (0)
#define PG8_WAIT_V(n) asm volatile("s_waitcnt vmcnt(" #n ")" ::: "memory")
#define PG8_WAIT_L(n) asm volatile("s_waitcnt lgkmcnt(" #n ")" ::: "memory")
#define PG8_BAR __builtin_amdgcn_s_barrier()
#define PG8_SCHED __builtin_amdgcn_sched_barrier(0)
#define PG8_ABASE(u) ((const char*)g.A + (size_t)(u).pm * tstepA + (g.npg ? (size_t)((u).pn / g.npg) * (size_t)g.a_gstride : (size_t)0))
    Unit cur, nxt; int ui = 0;
    if (!S.next(0, cur)) return;
    f32x4 acc[2][2][4][2];
    if constexpr (Epi::CINIT) E.init_acc(acc, cur, wc, fq);
    else {
#pragma unroll
    for (int a = 0; a < 2; ++a)
#pragma unroll
        for (int b = 0; b < 2; ++b)
#pragma unroll
            for (int m = 0; m < 4; ++m)
#pragma unroll
                for (int n = 0; n < 2; ++n) acc[a][b][m][n] = (f32x4){0.f, 0.f, 0.f, 0.f};
    }
    bf16x8 At[4][2], B0[2][2], B1[2][2];
    v8i_t At8[4], B08[2], B18[2];
    const int one_scale = 0x7F7F7F7F;
    const char* cA = PG8_ABASE(cur); const char* cB = (const char*)g.Bt + (size_t)cur.pn * tstepB;
    S.a_ready(cur);
    if constexpr (SP2) {
        PG8_STAGE(PG8_SB(0, 0), cB, voffB); PG8_STAGE(PG8_SB(0, 1), cB + hstepB, voffB); PG8_STAGE(PG8_SA(0, 0), cA, voffA); PG8_STAGE(PG8_SA(0, 1), cA + hstepA, voffA);
        if (wr == 1) PG8_BAR;
        PG8_WAIT_V(2); PG8_BAR;
        PG8_STAGE(PG8_SB(1, 0), cB + kstep, voffB); PG8_STAGE(PG8_SA(1, 0), cA + kstep, voffA); PG8_STAGE(PG8_SB(1, 1), cB + hstepB + kstep, voffB);
        PG8_WAIT_V(6); PG8_BAR;
    } else {
        PG8_STAGE(PG8_SB(0, 0), cB, voffB); PG8_STAGE(PG8_SA(0, 0), cA, voffA); PG8_STAGE(PG8_SB(0, 1), cB + hstepB, voffB); PG8_STAGE(PG8_SA(0, 1), cA + hstepA, voffA);
        if (wr == 1) PG8_BAR;
        PG8_WAIT_V(4); PG8_BAR;
        PG8_STAGE(PG8_SB(1, 0), cB + kstep, voffB); PG8_STAGE(PG8_SA(1, 0), cA + kstep, voffA); PG8_STAGE(PG8_SB(1, 1), cB + hstepB + kstep, voffB);
        PG8_WAIT_V(6); PG8_BAR;
    }
    for (;;) {
        const bool has_next = S.next(ui + 1, nxt);
        const char* nA = has_next ? PG8_ABASE(nxt) : cA; const char* nB = has_next ? (const char*)g.Bt + (size_t)nxt.pn * tstepB : cB;
        for (int t = 0; t < nt; t += 2) {
            const bool last = (t == nt - 2);
            const char* a1 = cA + (size_t)(t + 1) * kstep;
            const char* a2 = last ? nA : cA + (size_t)(t + 2) * kstep; const char* b2 = last ? nB : cB + (size_t)(t + 2) * kstep;
            const char* a3 = a2 + kstep; const char* b3 = b2 + kstep;
            if (last && has_next) S.a_ready(nxt);
            if constexpr (SP2) {
            PG8_LDB(B0, 0, 0); PG8_LDB(B1, 0, 1); PG8_SCHED; PG8_LDA(At, 0, 0); PG8_STAGE(PG8_SA(1, 1), a1 + hstepA, voffA);
            PG8_WAIT_V(8); PG8_WAIT_L(0); PG8_BAR; PG8_MMA(0, 0, At, B0); PG8_MMA(0, 1, At, B1); PG8_BAR; PG8_SCHED;
            PG8_LDA(At, 0, 1); PG8_STAGE(PG8_SB(0, 0), b2, voffB); PG8_STAGE(PG8_SB(0, 1), b2 + hstepB, voffB); PG8_STAGE(PG8_SA(0, 0), a2, voffA);
            PG8_WAIT_V(8); PG8_WAIT_L(0); PG8_BAR; PG8_MMA(1, 0, At, B0); PG8_MMA(1, 1, At, B1); PG8_BAR; PG8_SCHED;
            PG8_LDB(B0, 1, 0); PG8_LDB(B1, 1, 1); PG8_SCHED; PG8_LDA(At, 1, 0); PG8_STAGE(PG8_SA(0, 1), a2 + hstepA, voffA);
            PG8_WAIT_V(8); PG8_WAIT_L(0); PG8_BAR; PG8_MMA(0, 0, At, B0); PG8_MMA(0, 1, At, B1); PG8_BAR; PG8_SCHED;
            PG8_LDA(At, 1, 1); PG8_STAGE(PG8_SB(1, 0), b3, voffB); PG8_STAGE(PG8_SB(1, 1), b3 + hstepB, voffB); PG8_STAGE(PG8_SA(1, 0), a3, voffA);
            PG8_WAIT_V(8); PG8_WAIT_L(0); PG8_BAR; PG8_MMA(1, 0, At, B0); PG8_MMA(1, 1, At, B1); PG8_BAR; PG8_SCHED;
            } else {
            PG8_LDB(B0, 0, 0); PG8_SCHED; PG8_LDA(At, 0, 0); PG8_STAGE(PG8_SA(1, 1), a1 + hstepA, voffA);
            PG8_WAIT_L(8); PG8_BAR; PG8_WAIT_L(0); PG8_MMA(0, 0, At, B0); PG8_BAR; PG8_SCHED;
            PG8_LDB(B1, 0, 1); PG8_STAGE(PG8_SB(0, 0), b2, voffB);
            PG8_BAR; PG8_WAIT_L(0); PG8_MMA(0, 1, At, B1); PG8_BAR;
            PG8_LDA(At, 0, 1); PG8_STAGE(PG8_SA(0, 0), a2, voffA);
            PG8_BAR; PG8_WAIT_L(0); PG8_MMA(1, 0, At, B0); PG8_BAR; PG8_SCHED;
            PG8_STAGE(PG8_SB(0, 1), b2 + hstepB, voffB);
            PG8_WAIT_V(6); PG8_BAR; PG8_MMA(1, 1, At, B1); PG8_BAR;
            PG8_LDB(B0, 1, 0); PG8_SCHED; PG8_LDA(At, 1, 0); PG8_STAGE(PG8_SA(0, 1), a2 + hstepA, voffA);
            PG8_WAIT_L(8); PG8_BAR; PG8_WAIT_L(0); PG8_MMA(0, 0, At, B0); PG8_BAR; PG8_SCHED;
            PG8_LDB(B1, 1, 1); PG8_STAGE(PG8_SB(1, 0), b3, voffB);
            PG8_BAR; PG8_WAIT_L(0); PG8_MMA(0, 1, At, B1); PG8_BAR;
            PG8_LDA(At, 1, 1); PG8_STAGE(PG8_SA(1, 0), a3, voffA);
            PG8_BAR; PG8_WAIT_L(0); PG8_MMA(1, 0, At, B0); PG8_BAR; PG8_SCHED;
            PG8_STAGE(PG8_SB(1, 1), b3 + hstepB, voffB);
            PG8_WAIT_V(6); PG8_BAR; PG8_MMA(1, 1, At, B1); PG8_BAR;
            }
        }
        if constexpr (ALIGN_EPI) { if (wr == 0) PG8_BAR; }
        if constexpr (F8) asm volatile("s_nop 7\n\ts_nop 7\n\ts_nop 7" ::: "memory");
        if constexpr (!Epi::AFTER_DRAIN) { E(acc, cur, wr, wc, fr, fq); S.done(cur); }
        if (!has_next) break;
        if constexpr (Epi::CINIT) E.init_acc(acc, nxt, wc, fq);
        else {
#pragma unroll
        for (int a = 0; a < 2; ++a)
#pragma unroll
            for (int b = 0; b < 2; ++b)
#pragma unroll
                for (int m = 0; m < 4; ++m)
#pragma unroll
                    for (int n = 0; n < 2; ++n) acc[a][b][m][n] = (f32x4){0.f, 0.f, 0.f, 0.f};
        }
        cur = nxt; cA = nA; cB = nB; ++ui;
        if constexpr (ALIGN_EPI) { if (wr == 1) PG8_BAR; }
    }
    PG8_WAIT_V(0);
    if constexpr (!ALIGN_EPI) { if (wr == 0) PG8_BAR; }
    PG8_BAR;
#undef PG8_SA
#undef PG8_SB
#undef PG8_STAGE
#undef PG8_LDA
#undef PG8_LDB
#undef PG8_MMA
#undef PG8_WAIT_V
#undef PG8_WAIT_L
#undef PG8_BAR
#undef PG8_SCHED
#undef PG8_ABASE
}
}

#ifndef PG8_SP2
#define PG8_SP2 true
#endif
#ifndef PG8_ALIGN
#define PG8_ALIGN true
#endif

constexpr int NWAVES = 8;
constexpr int BATCH = 8, SEQ = 2048, DM = 4096, M = BATCH * SEQ, MEMLEN = 256, MMEM = BATCH * MEMLEN, DFF = 16384;
constexpr int POOLW = 3072, POOLG = 768, KVW = 6144, KVUW = 10240;
constexpr int NQ0 = 12288;

constexpr size_t MiB = 1u << 20;
constexpr size_t WS_CTL = 0, CTL_ZERO_BYTES = 1 * MiB;
constexpr size_t CTL_EVCNT = 768 * 1024;
constexpr size_t CTL_SS = 256 * 1024;
constexpr size_t WS_SS0 = 1 * MiB;
constexpr size_t WS_SSQ0 = 3 * MiB + 512 * 1024;
constexpr size_t WS_LSE = 2 * MiB;
constexpr size_t WS_EV = WS_LSE;
constexpr size_t WS_MKV = 4 * MiB;
constexpr size_t WS_MEMB = 20 * MiB;
constexpr size_t WS_WPG = 36 * MiB;
constexpr size_t WS_WAIN = 42 * MiB;
constexpr size_t WS_WMEMKV = 74 * MiB;
constexpr size_t WS_WAOUT = 106 * MiB;
constexpr size_t WS_XB8 = 900 * MiB;
constexpr size_t WS_WOUTP = 874 * MiB;
constexpr size_t WS_WKVB = 138 * MiB;
constexpr size_t WS_WBOUT = 218 * MiB;
constexpr size_t WS_W1 = 234 * MiB;
constexpr size_t WS_W2 = 490 * MiB;
constexpr size_t WS_XB = 746 * MiB;
constexpr size_t WS_X1 = 874 * MiB;
constexpr size_t WS_R = 1130 * MiB;
constexpr size_t WS_HID = WS_R;
constexpr size_t WS_U = WS_R, WS_POOLED = WS_R + 128 * MiB, WS_CAT = WS_R + 224 * MiB;
constexpr size_t WS_KVU = WS_R, WS_OG = WS_R + 320 * MiB, WS_CAT2 = WS_R + 416 * MiB;
constexpr size_t WS_END = 1642 * MiB;
constexpr int CW_TMO = 0, CW_CODE = 1, CW_BAR = 4096;

constexpr int RING_OFF = 0, RING_BYTES = 131072;
constexpr int LDSCTL_OFF = 143360, MISC_OFF = LDSCTL_OFF + 320;
constexpr int LDS_BYTES = 147456;

#define GAS __attribute__((address_space(1)))
#define LAS __attribute__((address_space(3)))
typedef unsigned short bf16;
typedef unsigned v4u __attribute__((ext_vector_type(4)));
typedef unsigned v2u __attribute__((ext_vector_type(2)));
typedef float f32x4 __attribute__((ext_vector_type(4)));
typedef short bf16x8 __attribute__((ext_vector_type(8)));
typedef short s16x4 __attribute__((ext_vector_type(4)));
typedef GAS unsigned gu32;
#define RLX_AGENT __ATOMIC_RELAXED, __HIP_MEMORY_SCOPE_AGENT
#define LDS_WAIT() asm volatile("s_waitcnt lgkmcnt(0)" ::: "memory")
#define VM_WAIT() asm volatile("s_waitcnt vmcnt(0)" ::: "memory")
__device__ __forceinline__ unsigned f2bf(float f) { unsigned u = __builtin_bit_cast(unsigned, f); return (u + 0x7fffu + ((u >> 16) & 1u)) >> 16; }
__device__ __forceinline__ unsigned pk2(float lo, float hi) { return f2bf(lo) | (f2bf(hi) << 16); }
__device__ __forceinline__ float bflo(unsigned w) { return __builtin_bit_cast(float, w << 16); }
__device__ __forceinline__ float bfhi(unsigned w) { return __builtin_bit_cast(float, w & 0xffff0000u); }

#define XB_TMO      128
#define XB_XCNT(j)  (256  + 64 * (j))
#define XB_XSUB(j)  (1280 + 64 * (j))
#define XB_XGEN(j)  (2304 + 64 * (j))
#define XB_TOP      3328
#define XB_TOPGEN   3392
#define XCD_BAR_WORDS 3456
#define XB_SPIN_CAP (1u << 22)
__device__ __forceinline__ unsigned xb_ld(unsigned* p)              { return __hip_atomic_load(p, __ATOMIC_RELAXED, __HIP_MEMORY_SCOPE_AGENT); }
__device__ __forceinline__ unsigned xb_add(unsigned* p, unsigned v) { return __hip_atomic_fetch_add(p, v, __ATOMIC_RELAXED, __HIP_MEMORY_SCOPE_AGENT); }
__device__ __forceinline__ unsigned xb_xcc_id() { return (unsigned)__builtin_amdgcn_s_getreg((3 << 11) | 20) & 0xFu; }
#define XB_SPIN(cond, bar) do { unsigned _sp = 0; while (cond) { __builtin_amdgcn_s_sleep(1); \
    if ((++_sp & 255u) == 0u) { if (xb_ld(&(bar)[XB_TMO])) break; if (_sp > XB_SPIN_CAP) { atomicAdd(&(bar)[XB_TMO], 1u); break; } } } } while (0)
struct XcdBarrier { unsigned* bar; unsigned x; volatile LAS unsigned* st; };
__device__ __forceinline__ XcdBarrier xcd_barrier_post(unsigned* bar, volatile LAS unsigned* st, bool leader  ) {
    XcdBarrier b; b.bar = bar; b.x = xb_xcc_id(); b.st = st;
    if (leader) (void)xb_add(&bar[XB_XCNT(b.x)], 1u);
    return b;
}
__device__ __forceinline__ void xcd_barrier_complete(unsigned* bar, unsigned x, unsigned& nloc, unsigned& nx) {
    const unsigned G = gridDim.x * gridDim.y * gridDim.z;
    unsigned sum, cnt, mine, sp = 0u;
    for (;;) {
        sum = 0u; cnt = 0u; mine = 0u;
#pragma unroll
        for (unsigned j = 0; j < 16; ++j) { const unsigned c = xb_ld(&bar[XB_XCNT(j)]); sum += c; cnt += (c > 0u) ? 1u : 0u; mine = (j == x) ? c : mine; }
        if (sum == G) break;
        __builtin_amdgcn_s_sleep(1);
        if ((++sp & 255u) == 0u) { if (xb_ld(&bar[XB_TMO])) break; if (sp > XB_SPIN_CAP) { atomicAdd(&bar[XB_TMO], 1u); break; } }
    }
    nloc = mine > 0u ? mine : 1u; nx = cnt > 0u ? cnt : 1u;
}
__device__ __forceinline__ void xcd_barrier(const XcdBarrier& b, bool leader  ) {
    asm volatile("s_waitcnt vmcnt(0)" ::: "memory");
    __syncthreads();
    if (leader) {
        unsigned* bar = b.bar;
        __builtin_amdgcn_s_waitcnt(0);
        unsigned nloc = b.st[0], nx = b.st[1];
        if (nloc == 0u) { xcd_barrier_complete(bar, b.x, nloc, nx); b.st[0] = nloc; b.st[1] = nx; }
        const unsigned old = xb_add(&bar[XB_XSUB(b.x)], 1u);
        const unsigned gen = old / nloc;
        if (old + 1u == (gen + 1u) * nloc) {
            __builtin_amdgcn_fence(__ATOMIC_RELEASE, "agent");
            asm volatile("s_waitcnt vmcnt(0)" ::: "memory");
            const unsigned og = xb_add(&bar[XB_TOP], 1u);
            const unsigned tg = og / nx;
            if (og + 1u == (tg + 1u) * nx) xb_add(&bar[XB_TOPGEN], 1u);
            else XB_SPIN(xb_ld(&bar[XB_TOPGEN]) == tg, bar);
            __builtin_amdgcn_fence(__ATOMIC_ACQUIRE, "agent");
            xb_add(&bar[XB_XGEN(b.x)], 1u);
            asm volatile("s_waitcnt vmcnt(0)" ::: "memory");
        } else {
            XB_SPIN(xb_ld(&bar[XB_XGEN(b.x)]) == gen, bar);
            __builtin_amdgcn_fence(__ATOMIC_ACQUIRE, "agent");
            asm volatile("s_waitcnt vmcnt(0)" ::: "memory");
        }
    }
    __syncthreads();
}

struct Frame {
    LAS unsigned char* lds;
    volatile LAS unsigned* MISC;
    gu32* ctl;
    int wave;
    int vcu, G;
};

__device__ __forceinline__ float wave_sum(float v) {
#pragma unroll
    for (int o = 1; o < 64; o <<= 1) v += __shfl_xor(v, o);
    return v;
}
template <int Q = 0>
__device__ __forceinline__ void p0_transpose_item(const float* W, int N, bf16* WT, int ldo, int row_off, const float* gk, const float* gn, LAS float* scr, int item, int lane, float qscale = pg8::I8_SW, int ncol = 0) {
    constexpr bool F8 = (Q != 0);
    const int nblk = (ncol ? ncol : N) / 64, kb = item / nblk, nb = item % nblk, n0 = 64 * nb;
    const int lr = lane >> 4, lq = lane & 15;
    const int c = lane & 7, nn = lane >> 3;
#pragma unroll 1
    for (int h = 0; h < (F8 ? 2 : 1); ++h) {
    const int k0 = F8 ? 128 * kb + 64 * h : 64 * kb;
    const float* src = W + (size_t)(k0 + lr) * N + n0 + 4 * lq;
    f32x4 v[16];
#pragma unroll
    for (int i = 0; i < 16; ++i) v[i] = *(const GAS f32x4*)(src + (size_t)(4 * i) * N);
    float gkv[8];
#pragma unroll
    for (int e = 0; e < 8; ++e) gkv[e] = gk ? gk[k0 + 8 * c + e] : 1.0f;
#pragma unroll
    for (int i = 0; i < 16; ++i) { LAS float* d = scr + (4 * i + lr) * 65 + 4 * lq; d[0] = v[i].x; d[1] = v[i].y; d[2] = v[i].z; d[3] = v[i].w; }
    LDS_WAIT(); asm volatile("" ::: "memory");
#pragma unroll
    for (int j = 0; j < 8; ++j) { const int n = 8 * j + nn; const LAS float* s = scr + (8 * c) * 65 + n; const float gg = (gn ? gn[n0 + n] : 1.0f) * (Q == 1 ? 64.0f : (Q == 2 ? qscale : 1.0f));
        if constexpr (Q == 2) {
            *(GAS v2u*)((unsigned char*)WT + (size_t)(row_off + n0 + n) * ldo + k0 + 8 * c) = (v2u){pg8::pack_q8(s[0 * 65] * gkv[0] * gg, s[1 * 65] * gkv[1] * gg, s[2 * 65] * gkv[2] * gg, s[3 * 65] * gkv[3] * gg),
                                                                                                      pg8::pack_q8(s[4 * 65] * gkv[4] * gg, s[5 * 65] * gkv[5] * gg, s[6 * 65] * gkv[6] * gg, s[7 * 65] * gkv[7] * gg)};
        } else if constexpr (Q == 1) {
            int p0 = __builtin_amdgcn_cvt_pk_fp8_f32(s[0 * 65] * gkv[0] * gg, s[1 * 65] * gkv[1] * gg, 0, false); p0 = __builtin_amdgcn_cvt_pk_fp8_f32(s[2 * 65] * gkv[2] * gg, s[3 * 65] * gkv[3] * gg, p0, true);
            int p1 = __builtin_amdgcn_cvt_pk_fp8_f32(s[4 * 65] * gkv[4] * gg, s[5 * 65] * gkv[5] * gg, 0, false); p1 = __builtin_amdgcn_cvt_pk_fp8_f32(s[6 * 65] * gkv[6] * gg, s[7 * 65] * gkv[7] * gg, p1, true);
            *(GAS v2u*)((unsigned char*)WT + (size_t)(row_off + n0 + n) * ldo + k0 + 8 * c) = (v2u){(unsigned)p0, (unsigned)p1};
        } else {
        v4u o; o.x = pk2(s[0 * 65] * gkv[0] * gg, s[1 * 65] * gkv[1] * gg); o.y = pk2(s[2 * 65] * gkv[2] * gg, s[3 * 65] * gkv[3] * gg);
        o.z = pk2(s[4 * 65] * gkv[4] * gg, s[5 * 65] * gkv[5] * gg); o.w = pk2(s[6 * 65] * gkv[6] * gg, s[7 * 65] * gkv[7] * gg);
        *(GAS v4u*)(WT + (size_t)(row_off + n0 + n) * ldo + k0 + 8 * c) = o; } }
    LDS_WAIT(); asm volatile("" ::: "memory");
    }
}
__device__ __forceinline__ void row_to_bf16_ss(int lane, const float* xrow, bf16* orow, pg8::ssq_t* ssp) {
    const GAS f32x4* xr = (const GAS f32x4*)xrow + lane;
    GAS unsigned long long* o8 = (GAS unsigned long long*)orow + lane;
    float s = 0.f;
#pragma unroll
    for (int j = 0; j < 16; ++j) { const f32x4 v = xr[64 * j]; s += (v.x * v.x + v.y * v.y) + (v.z * v.z + v.w * v.w);
        o8[64 * j] = (unsigned long long)pk2(v.x, v.y) | ((unsigned long long)pk2(v.z, v.w) << 32); }
    s = wave_sum(s);
    if (lane == 0) *ssp = pg8::ssq_from(s);
}

__device__ __forceinline__ void row_to_q8(int lane, const float* xrow, unsigned char* qrow) {
    const GAS f32x4* xr = (const GAS f32x4*)xrow + lane;
    f32x4 v[16]; float s = 0.f;
#pragma unroll
    for (int j = 0; j < 16; ++j) { v[j] = xr[64 * j]; s += (v[j].x * v[j].x + v[j].y * v[j].y) + (v[j].z * v[j].z + v[j].w * v[j].w); }
    s = wave_sum(s);
    const float r = pg8::rstd_of(pg8::ssq_from(s)) * pg8::I8_SA; GAS unsigned* q = (GAS unsigned*)qrow + lane;
#pragma unroll
    for (int j = 0; j < 16; ++j) q[64 * j] = pg8::pack_q8(v[j].x * r, v[j].y * r, v[j].z * r, v[j].w * r);
}

struct Ptrs {
    const float *x, *mem, *a_norm, *a_w_in, *a_w_pg, *a_scale, *a_w_out, *kv_norm, *w_kv, *b_norm, *b_w_in, *b_w_out, *mem_norm, *w_mem_kv, *mlp_norm, *mlp_w1, *mlp_w2, *rel_bias, *final_norm;
};

__device__ __forceinline__ void p0_prologue(Frame& F, const Ptrs& P, unsigned char* ws) {
    const int lane = lane_id(), tid = F.wave * 64 + lane;
    LAS float* scr = (LAS float*)(F.lds + RING_OFF + F.wave * 16640);
    const int gw = F.vcu * NWAVES + F.wave, NGW = F.G * NWAVES;
    bf16* WAIN = (bf16*)(ws + WS_WAIN); bf16* WMEMKV = (bf16*)(ws + WS_WMEMKV); bf16* WPG = (bf16*)(ws + WS_WPG); bf16* WAOUT = (bf16*)(ws + WS_WAOUT);
    bf16* WKVB = (bf16*)(ws + WS_WKVB); bf16* WBOUT = (bf16*)(ws + WS_WBOUT); bf16* W1 = (bf16*)(ws + WS_W1); bf16* W2 = (bf16*)(ws + WS_W2);
    constexpr int I_SQ = (DM / 64) * (DM / 64);
    constexpr int I_MKV = (DM / 128) * (2048 / 64);
    constexpr int I_PG = (POOLG / 64) * (POOLG / 64);
    constexpr int I_W2 = (DFF / 64) * (DM / 64);
    constexpr int I_KV = (DM / 128) * (KVW / 64);
    constexpr int I_BIN = (DM / 128) * (DM / 64);
    constexpr int I_BO = (2048 / 128) * (DM / 64);
    constexpr int I_W1Q = (DM / 128) * (DFF / 64);
    constexpr int I_W2Q = (DFF / 128) * (DM / 64);
    constexpr int I_W1A = (DM / 128) * (NQ0 / 64), I_W1B = (DM / 64) * ((DFF - NQ0) / 64);
    constexpr int NITEMS = 2 * I_SQ + I_BIN + 2 * I_MKV + I_W1A + I_W1B + I_W1Q + I_W2 + I_W2Q + I_KV + I_BO;
    for (int it = gw; it < NITEMS; it += NGW) {
        int r = it;
        if (r < I_W1A) { p0_transpose_item<2>(P.mlp_w1, DFF, W1, DM, 0, P.mlp_norm, nullptr, scr, r, lane, pg8::I8_SW, NQ0); continue; } r -= I_W1A;
        if (r < I_W1B) { p0_transpose_item(P.mlp_w1 + NQ0, DFF, W1 + (size_t)32 * 1024 * 1024, DM, 0, P.mlp_norm, nullptr, scr, r, lane, 1.0f, DFF - NQ0); continue; } r -= I_W1B;
        if (r < I_W1Q) { p0_transpose_item<2>(P.mlp_w1 + (size_t)DM * DFF, DFF, W1 + (size_t)DFF * DM, DM, 0, P.mlp_norm + DM, nullptr, scr, r, lane); continue; } r -= I_W1Q;
        if (r < I_W2) { p0_transpose_item(P.mlp_w2, DM, W2, DFF, 0, nullptr, nullptr, scr, r, lane); continue; } r -= I_W2;
        if (r < I_W2Q) { p0_transpose_item<2>(P.mlp_w2 + (size_t)DFF * DM, DM, W2 + (size_t)DM * DFF, DFF, 0, nullptr, nullptr, scr, r, lane, pg8::I8_SW2); continue; } r -= I_W2Q;
        if (r < I_KV) { p0_transpose_item<2>(P.w_kv, KVW, WKVB, DM, 0, P.kv_norm, nullptr, scr, r, lane); continue; } r -= I_KV;
        if (r < I_BIN) { p0_transpose_item<2>(P.b_w_in, DM, WKVB, DM, KVW, P.b_norm, nullptr, scr, r, lane); continue; } r -= I_BIN;
        if (r < I_SQ) { p0_transpose_item(P.a_w_in, DM, WAIN, DM, 0, P.a_norm, nullptr, scr, r, lane); continue; } r -= I_SQ;
        if (r < I_SQ) { const bool poolrows = (r / (DM / 64)) * 64 < POOLW;
            p0_transpose_item(P.a_w_out, DM, poolrows ? (bf16*)(ws + WS_WOUTP) : WAOUT, poolrows ? POOLW : DM, 0, nullptr, nullptr, scr, r, lane); continue; } r -= I_SQ;
        if (r < 2 * I_MKV) { const int l = r / I_MKV; r -= l * I_MKV; p0_transpose_item<2>(P.w_mem_kv + (size_t)l * DM * 2048, 2048, WMEMKV, DM, l * 2048, P.mem_norm, nullptr, scr, r, lane); continue; } r -= 2 * I_MKV;
        p0_transpose_item<1>(P.b_w_out, DM, WBOUT, 2048, 0, nullptr, nullptr, scr, r, lane);
    }
    bf16* XB = (bf16*)(ws + WS_XB); pg8::ssq_t* ss0 = (pg8::ssq_t*)(ws + WS_SSQ0);
    for (int m = gw; m < M + MMEM + POOLW; m += NGW) {
        if (m < M) row_to_bf16_ss(lane, P.x + (size_t)m * DM, XB + (size_t)m * DM, ss0 + m);
        else if (m < M + MMEM) { const int mm = m - M; row_to_q8(lane, P.mem + (size_t)mm * DM, ws + WS_MEMB + (size_t)mm * DM); }
        else { const int rr = m - M - MMEM, g = rr / POOLG;
            const GAS f32x4* wr_ = (const GAS f32x4*)(P.a_w_pg + (size_t)rr * POOLG) + lane; const GAS f32x4* sc = (const GAS f32x4*)(P.a_scale + g * POOLG) + lane;
            GAS unsigned long long* o8 = (GAS unsigned long long*)(WPG + (size_t)rr * POOLG) + lane;
#pragma unroll
            for (int j = 0; j < 3; ++j) { const f32x4 v = wr_[64 * j] * sc[64 * j]; o8[64 * j] = (unsigned long long)pk2(v.x, v.y) | ((unsigned long long)pk2(v.z, v.w) << 32); } }
    }
    float* BT = (float*)(ws + WS_SS0 + 131072);
    for (int i = (int)blockIdx.x * 512 + tid; i < 24 * 129; i += F.G * 512) {
        const int gh = i / 129, delta = i % 129, g = gh >> 3, dil = g == 0 ? 1 : (g == 1 ? 4 : 16), dist = delta * dil;
        int bucket = dist;
        if (dist >= 16) { const float d32 = (float)dist; int lg = 16 + (int)(logf(d32 / 16.0f) / 4.852030263919617f * 16.0f); bucket = lg < 31 ? lg : 31; }
        BT[i] = P.rel_bias[bucket * 24 + gh];
    }
}

template <int D> struct AttnItem {
    const bf16* q; size_t qstride;
    const bf16* k; const bf16* v; size_t kstride;
    int key_lo;
    bf16* o; size_t ostride;
    unsigned char* o8;
    float* lse; int lse_stride;
    const float* bias;
};
#define ATT_WAIT0() asm volatile("s_waitcnt vmcnt(0) lgkmcnt(0)" ::: "memory")
template <int OFF> __device__ __forceinline__ s16x4 att_tr_read(unsigned vb) { s16x4 r; asm volatile("ds_read_b64_tr_b16 %0, %1 offset:%2" : "=&v"(r) : "v"(vb), "i"(OFF) : "memory"); return r; }
template <int D, int S, int DB0> __device__ __forceinline__ void att_pv4(f32x4 (&oacc)[D / 16], const unsigned (&vb)[D / 16], const bf16x8 p) {
    constexpr int HIOFF = (D == 256 && S >= 4) ? 65536 : 0, OFF0 = (32 * S) * (2 * D) - HIOFF, OFF1 = OFF0 + 16 * (2 * D);
    const s16x4 a0 = att_tr_read<OFF0>(vb[DB0 + 0] + HIOFF), a1 = att_tr_read<OFF1>(vb[DB0 + 0] + HIOFF), b0 = att_tr_read<OFF0>(vb[DB0 + 1] + HIOFF), b1 = att_tr_read<OFF1>(vb[DB0 + 1] + HIOFF);
    const s16x4 c0 = att_tr_read<OFF0>(vb[DB0 + 2] + HIOFF), c1 = att_tr_read<OFF1>(vb[DB0 + 2] + HIOFF), d0 = att_tr_read<OFF0>(vb[DB0 + 3] + HIOFF), d1 = att_tr_read<OFF1>(vb[DB0 + 3] + HIOFF);
    asm volatile("s_waitcnt lgkmcnt(0)" ::: "memory"); __builtin_amdgcn_sched_barrier(0);
    oacc[DB0 + 0] = __builtin_amdgcn_mfma_f32_16x16x32_bf16(__builtin_shufflevector(a0, a1, 0, 1, 2, 3, 4, 5, 6, 7), p, oacc[DB0 + 0], 0, 0, 0);
    oacc[DB0 + 1] = __builtin_amdgcn_mfma_f32_16x16x32_bf16(__builtin_shufflevector(b0, b1, 0, 1, 2, 3, 4, 5, 6, 7), p, oacc[DB0 + 1], 0, 0, 0);
    oacc[DB0 + 2] = __builtin_amdgcn_mfma_f32_16x16x32_bf16(__builtin_shufflevector(c0, c1, 0, 1, 2, 3, 4, 5, 6, 7), p, oacc[DB0 + 2], 0, 0, 0);
    oacc[DB0 + 3] = __builtin_amdgcn_mfma_f32_16x16x32_bf16(__builtin_shufflevector(d0, d1, 0, 1, 2, 3, 4, 5, 6, 7), p, oacc[DB0 + 3], 0, 0, 0);
}
template <int D, int S> __device__ __forceinline__ void att_pv_step(f32x4 (&oacc)[D / 16], const unsigned (&vb)[D / 16], const bf16x8 p) {
    att_pv4<D, S, 0>(oacc, vb, p); att_pv4<D, S, 4>(oacc, vb, p);
    if constexpr (D == 256) { att_pv4<D, S, 8>(oacc, vb, p); att_pv4<D, S, 12>(oacc, vb, p); }
}
#define ATT_BAR() do { asm volatile("" ::: "memory"); __builtin_amdgcn_s_barrier(); asm volatile("" ::: "memory"); } while (0)
template <int D, bool DIL, class Maker>
__device__ __forceinline__ void attn_run(LAS unsigned char* lds, const Maker& mk, int first, int stride, int nitems, const int w  ) {
    const int lane = lane_id(), tid = w * 64 + lane;
    constexpr int NDC = D / 64, NKB = 2 * NDC, NV = D / 16, CPR = D / 8, RPB = 64 / CPR;
    constexpr int KOFF = 0, VOFF = (D == 128) ? 65536 : 0, BTOFF = 131072;
    if (first >= nitems) return;
    const int g = lane >> 4, c = lane & 15;
    LAS float* bt = (LAS float*)(lds + BTOFF);
    int Rk[2], Ck[2];
#pragma unroll
    for (int i = 0; i < 2; ++i) pg8::stage_rc(tid * 16 + i * 8192, Rk[i], Ck[i]);
    const int vrow = lane / CPR, vpos = lane % CPR;
    const int q4 = c >> 2, p4 = c & 3, sw3 = 4 * (g & 1) + q4;
    const unsigned vlane = VOFF + (4 * g + q4) * (2 * D) + 8 * (p4 & 1) + 16 * (p4 >> 1);
    const unsigned klane = KOFF + pg8::lds_byte(c, 8 * g);
    const unsigned ldsbase = (unsigned)(size_t)lds;
    bf16x8 qf[D / 32];
    f32x4 sacc[16];
    f32x4 oacc[D / 16];
    bf16x8 pf[8];
    float rl = 1.f, rm = 0.f;
#define ATT_ISSUE_K(it) do { int wv = w; asm volatile("" : "+s"(wv)); _Pragma("unroll") for (int hb = 0; hb < NKB; ++hb) { _Pragma("unroll") for (int i = 0; i < 2; ++i) { int row = (hb / NDC) * 128 + Rk[i]; row = row < (it).key_lo ? (it).key_lo : row; \
        __builtin_amdgcn_global_load_lds((const unsigned*)((it).k + (size_t)row * (it).kstride + (hb % NDC) * 64 + Ck[i]), (LAS unsigned*)(lds + KOFF + hb * 16384 + i * 8192 + wv * 1024), 16, 0, 0); } } } while (0)
#define ATT_ISSUE_V(it) do { int wv = w; asm volatile("" : "+s"(wv)); _Pragma("unroll") for (int j = 0; j < NV; ++j) { const int row = (j * 8 + wv) * RPB + vrow; const int rowc = row < (it).key_lo ? (it).key_lo : row; const int ch = vpos ^ ((row & 7) << 1); \
        __builtin_amdgcn_global_load_lds((const unsigned*)((it).v + (size_t)rowc * (it).kstride + 8 * ch), (LAS unsigned*)(lds + VOFF + (j * 8 + wv) * 1024), 16, 0, 0); } } while (0)
#define ATT_LOAD_Q(it) do { const bf16* qp = (it).q + (size_t)(16 * w + c) * (it).qstride + 8 * g; _Pragma("unroll") for (int s = 0; s < D / 32; ++s) qf[s] = *(const GAS bf16x8*)(qp + 32 * s); } while (0)
#define ATT_S_SOFTMAX(it) do { int wv = w; asm volatile("" : "+s"(wv)); \
    const int kb_lo = DIL ? (wv > ((it).key_lo >> 4) ? wv : ((it).key_lo >> 4)) : 0, kb_hi = DIL ? wv + 8 : 15; \
    _Pragma("unroll") for (int kb = 0; kb < 16; ++kb) sacc[kb] = (f32x4){0.f, 0.f, 0.f, 0.f}; \
    _Pragma("unroll") for (int kb = 0; kb < 16; ++kb) { if (kb >= kb_lo && kb <= kb_hi) { \
        _Pragma("unroll") for (int s = 0; s < D / 32; ++s) { \
            const bf16x8 kf = *(const LAS bf16x8*)(lds + klane + ((kb >> 3) * NDC + (s >> 1)) * 16384 + ((kb & 7) * 2 + (s & 1)) * 1024); \
            sacc[kb] = __builtin_amdgcn_mfma_f32_16x16x32_bf16(kf, qf[s], sacc[kb], 0, 0, 0); } } } \
    const float scale = DIL ? 0.08838834764831845f : 0.0625f; int ql = 16 * wv + c; asm volatile("" : "+v"(ql)); float mx = -3.0e38f; \
    _Pragma("unroll") for (int kb = 0; kb < 16; ++kb) { _Pragma("unroll") for (int r = 0; r < 4; ++r) { float lg; \
        if (DIL) { const int kl = 16 * kb + 4 * g + r, delta = ql + 128 - kl; const bool ok = (kb >= kb_lo) && (kb <= kb_hi) && delta >= 0 && delta <= 128 && kl >= (it).key_lo; \
            const int di = delta < 0 ? 0 : (delta > 128 ? 128 : delta); lg = ok ? sacc[kb][r] * scale + bt[di] : -3.0e38f; } \
        else lg = sacc[kb][r] * scale; \
        sacc[kb][r] = lg; mx = fmaxf(mx, lg); } } \
    mx = fmaxf(mx, __shfl_xor(mx, 16)); mx = fmaxf(mx, __shfl_xor(mx, 32)); float sum = 0.f; \
    _Pragma("unroll") for (int kb = 0; kb < 16; ++kb) { _Pragma("unroll") for (int r = 0; r < 4; ++r) { const float lg = sacc[kb][r]; const float p = lg > -1.0e38f ? __expf(lg - mx) : 0.f; sacc[kb][r] = p; sum += p; } } \
    sum += __shfl_xor(sum, 16); sum += __shfl_xor(sum, 32); rl = sum; rm = mx; \
    _Pragma("unroll") for (int s = 0; s < 8; ++s) { v4u pw; pw.x = pk2(sacc[2 * s][0], sacc[2 * s][1]); pw.y = pk2(sacc[2 * s][2], sacc[2 * s][3]); pw.z = pk2(sacc[2 * s + 1][0], sacc[2 * s + 1][1]); pw.w = pk2(sacc[2 * s + 1][2], sacc[2 * s + 1][3]); \
        pf[s] = __builtin_bit_cast(bf16x8, pw); } } while (0)
#define ATT_PV_STORE(it) do { int wv = w; asm volatile("" : "+s"(wv)); \
    const int kb_lo = DIL ? (wv > ((it).key_lo >> 4) ? wv : ((it).key_lo >> 4)) : 0, kb_hi = DIL ? wv + 8 : 15; \
    _Pragma("unroll") for (int i = 0; i < D / 16; ++i) oacc[i] = (f32x4){0.f, 0.f, 0.f, 0.f}; \
    unsigned vb[D / 16]; _Pragma("unroll") for (int db = 0; db < D / 16; ++db) vb[db] = ldsbase + vlane + 32 * (db ^ sw3); \
    if (1 >= kb_lo && 0 <= kb_hi) att_pv_step<D, 0>(oacc, vb, pf[0]); \
    if (3 >= kb_lo && 2 <= kb_hi) att_pv_step<D, 1>(oacc, vb, pf[1]); \
    if (5 >= kb_lo && 4 <= kb_hi) att_pv_step<D, 2>(oacc, vb, pf[2]); \
    if (7 >= kb_lo && 6 <= kb_hi) att_pv_step<D, 3>(oacc, vb, pf[3]); \
    if (9 >= kb_lo && 8 <= kb_hi) att_pv_step<D, 4>(oacc, vb, pf[4]); \
    if (11 >= kb_lo && 10 <= kb_hi) att_pv_step<D, 5>(oacc, vb, pf[5]); \
    if (13 >= kb_lo && 12 <= kb_hi) att_pv_step<D, 6>(oacc, vb, pf[6]); \
    if (15 >= kb_lo && 14 <= kb_hi) att_pv_step<D, 7>(oacc, vb, pf[7]); \
    const float inv = 1.0f / rl; bf16* op = (it).o + (size_t)(16 * w + c) * (it).ostride + 4 * g; \
    if ((it).o8) { const float inv16 = inv * 16.0f; unsigned char* op8 = (it).o8 + (size_t)(16 * w + c) * (it).ostride + 4 * g; \
        _Pragma("unroll") for (int db = 0; db < D / 16; ++db) { int p = __builtin_amdgcn_cvt_pk_fp8_f32(oacc[db][0] * inv16, oacc[db][1] * inv16, 0, false); p = __builtin_amdgcn_cvt_pk_fp8_f32(oacc[db][2] * inv16, oacc[db][3] * inv16, p, true); *(GAS int*)(op8 + 16 * db) = p; } } \
    else { _Pragma("unroll") for (int db = 0; db < D / 16; ++db) { v2u o2; o2.x = pk2(oacc[db][0] * inv, oacc[db][1] * inv); o2.y = pk2(oacc[db][2] * inv, oacc[db][3] * inv); *(GAS v2u*)(op + 16 * db) = o2; } } \
    if (DIL) { if (g == 0) (it).lse[(size_t)(16 * w + c) * (it).lse_stride] = rm + __logf(rl); } } while (0)

#define ATT_QFENCE() do { _Pragma("unroll") for (int s = 0; s < D / 32; ++s) asm volatile("" :: "v"(qf[s])); } while (0)
#define ATT_ITEM(idv) ([&]() { int _i = (idv); asm volatile("" : "+s"(_i)); return mk(_i); }())
    if constexpr (D == 128) {
        int id = first;
        { const AttnItem<D> it = ATT_ITEM(id); ATT_ISSUE_K(it); ATT_LOAD_Q(it); }
        for (;;) {
            { const AttnItem<D> it = ATT_ITEM(id);
              if (DIL) { if (tid < 129) bt[tid] = it.bias[tid]; }
              ATT_WAIT0(); ATT_QFENCE(); ATT_BAR();
              ATT_ISSUE_V(it); }
            { const AttnItem<D> it = ATT_ITEM(id); ATT_S_SOFTMAX(it); }
            ATT_WAIT0(); ATT_BAR();
            const int nid = id + stride; const bool has_next = nid < nitems;
            if (has_next) { const AttnItem<D> it = ATT_ITEM(nid); ATT_ISSUE_K(it); ATT_LOAD_Q(it); }
            { const AttnItem<D> it = ATT_ITEM(id); ATT_PV_STORE(it); }
            if (!has_next) break;
            id = nid;
        }
    } else {
        for (int id = first; id < nitems; id += stride) {
            { const AttnItem<D> it = ATT_ITEM(id); ATT_ISSUE_K(it); ATT_LOAD_Q(it); }
            ATT_WAIT0(); ATT_QFENCE(); ATT_BAR();
            { const AttnItem<D> it = ATT_ITEM(id); ATT_S_SOFTMAX(it); }
            ATT_WAIT0(); ATT_BAR();
            { const AttnItem<D> it = ATT_ITEM(id); ATT_ISSUE_V(it); }
            ATT_WAIT0(); ATT_BAR();
            { const AttnItem<D> it = ATT_ITEM(id); ATT_PV_STORE(it); }
            ATT_WAIT0(); ATT_BAR();
        }
    }
#undef ATT_ITEM
#undef ATT_QFENCE
    ATT_WAIT0(); ATT_BAR();
#undef ATT_ISSUE_K
#undef ATT_ISSUE_V
#undef ATT_LOAD_Q
#undef ATT_S_SOFTMAX
#undef ATT_PV_STORE
}

__device__ __forceinline__ void pool_phase(Frame& F, const bf16* U, bf16* POOLED) {
    const int lane = lane_id();
    const int gw = F.vcu * NWAVES + F.wave, NGW = F.G * NWAVES;
    constexpr int NTC = SEQ / 64, NCC = POOLW / 512, NIT = BATCH * NTC * NCC;
    for (int itx = gw; itx < NIT; itx += NGW) {
        const int cc = itx % NCC, tc = (itx / NCC) % NTC, b = itx / (NCC * NTC);
        const int col = 512 * cc + 8 * lane, w = 2 << (col / POOLG);
        const int t0 = 64 * tc, ts = t0 >= 16 ? t0 - 16 : 0;
        const bf16* ub = U + (size_t)b * SEQ * DM + col;
        bf16* pb = POOLED + (size_t)b * SEQ * DM + col;
        float S[8];
#pragma unroll
        for (int j = 0; j < 8; ++j) S[j] = 0.f;
#pragma unroll 8
        for (int t = ts; t < t0 + 64; ++t) {
            const v4u cur = *(const GAS v4u*)(ub + (size_t)t * DM);
            const int to = (t - w >= ts) ? t - w : t; const float sg = (t - w >= ts) ? 1.f : 0.f;
            const v4u old = *(const GAS v4u*)(ub + (size_t)to * DM);
            float cv[8] = {bflo(cur.x), bfhi(cur.x), bflo(cur.y), bfhi(cur.y), bflo(cur.z), bfhi(cur.z), bflo(cur.w), bfhi(cur.w)};
            float ov[8] = {bflo(old.x), bfhi(old.x), bflo(old.y), bfhi(old.y), bflo(old.z), bfhi(old.z), bflo(old.w), bfhi(old.w)};
#pragma unroll
            for (int j = 0; j < 8; ++j) S[j] += cv[j] - sg * ov[j];
            if (t >= t0) { const float ic = 1.0f / (float)((t + 1) < w ? (t + 1) : w); v4u o;
                o.x = pk2(S[0] * ic - cv[0], S[1] * ic - cv[1]); o.y = pk2(S[2] * ic - cv[2], S[3] * ic - cv[3]); o.z = pk2(S[4] * ic - cv[4], S[5] * ic - cv[5]); o.w = pk2(S[6] * ic - cv[6], S[7] * ic - cv[7]);
                *(GAS v4u*)(pb + (size_t)t * DM) = o; }
        }
    }
}
__device__ __forceinline__ void merge_phase(Frame& F, const bf16* OG, const float* LSE, unsigned char* CAT2) {
    const int gw = F.vcu * NWAVES + F.wave, NGW = F.G * NWAVES;
    const int lane = lane_id(), h = lane >> 3, col = h * 128 + 16 * (lane & 7);
    for (int row = gw; row < M; row += NGW) {
        const float* lp = LSE + (size_t)row * 24 + h * 3;
        const float l0 = lp[0], l1 = lp[1], l2 = lp[2];
        const float mx = fmaxf(l0, fmaxf(l1, l2));
        float w0 = __expf(l0 - mx), w1 = __expf(l1 - mx), w2 = __expf(l2 - mx); const float inv = 1.0f / (w0 + w1 + w2); w0 *= inv; w1 *= inv; w2 *= inv;
        float acc[16];
#pragma unroll
        for (int j = 0; j < 16; ++j) acc[j] = 0.f;
#pragma unroll
        for (int g = 0; g < 3; ++g) { const float wg = g == 0 ? w0 : (g == 1 ? w1 : w2); const bf16* src = OG + (size_t)g * M * 1024 + (size_t)row * 1024 + col;
#pragma unroll
            for (int hh = 0; hh < 2; ++hh) { const v4u x = *(const GAS v4u*)(src + 8 * hh);
                acc[8 * hh + 0] += wg * bflo(x.x); acc[8 * hh + 1] += wg * bfhi(x.x); acc[8 * hh + 2] += wg * bflo(x.y); acc[8 * hh + 3] += wg * bfhi(x.y);
                acc[8 * hh + 4] += wg * bflo(x.z); acc[8 * hh + 5] += wg * bfhi(x.z); acc[8 * hh + 6] += wg * bflo(x.w); acc[8 * hh + 7] += wg * bfhi(x.w); } }
        v4u o;
        { int p = __builtin_amdgcn_cvt_pk_fp8_f32(acc[0] * 16.f, acc[1] * 16.f, 0, false); p = __builtin_amdgcn_cvt_pk_fp8_f32(acc[2] * 16.f, acc[3] * 16.f, p, true); o.x = (unsigned)p; }
        { int p = __builtin_amdgcn_cvt_pk_fp8_f32(acc[4] * 16.f, acc[5] * 16.f, 0, false); p = __builtin_amdgcn_cvt_pk_fp8_f32(acc[6] * 16.f, acc[7] * 16.f, p, true); o.y = (unsigned)p; }
        { int p = __builtin_amdgcn_cvt_pk_fp8_f32(acc[8] * 16.f, acc[9] * 16.f, 0, false); p = __builtin_amdgcn_cvt_pk_fp8_f32(acc[10] * 16.f, acc[11] * 16.f, p, true); o.z = (unsigned)p; }
        { int p = __builtin_amdgcn_cvt_pk_fp8_f32(acc[12] * 16.f, acc[13] * 16.f, 0, false); p = __builtin_amdgcn_cvt_pk_fp8_f32(acc[14] * 16.f, acc[15] * 16.f, p, true); o.w = (unsigned)p; }
        *(GAS v4u*)(CAT2 + (size_t)row * 2048 + col) = o;
    }
}
__device__ __forceinline__ void w2q_colsum_phase(Frame& F, const unsigned char* W2Q, int* CS) {
    const int gw = F.vcu * NWAVES + F.wave, NGW = F.G * NWAVES, lane = lane_id();
    for (int n = gw; n < DM; n += NGW) {
        const GAS v4u* p = (const GAS v4u*)(W2Q + (size_t)n * DFF) + lane;
        v4u x[16];
#pragma unroll
        for (int j = 0; j < 16; ++j) x[j] = p[64 * j];
        int s = 0;
#define W2Q_BSUM(u) { const int w = (int)(u); s += ((w << 24) >> 24) + ((w << 16) >> 24) + ((w << 8) >> 24) + (w >> 24); }
#pragma unroll
        for (int j = 0; j < 16; ++j) { W2Q_BSUM(x[j].x) W2Q_BSUM(x[j].y) W2Q_BSUM(x[j].z) W2Q_BSUM(x[j].w) }
#undef W2Q_BSUM
#pragma unroll
        for (int o = 1; o < 64; o <<= 1) s += __shfl_xor(s, o);
        if (lane == 0) CS[n] = 128 * s;
    }
}
__device__ __forceinline__ void final_norm_phase(Frame& F, const bf16* XB, float* out, const float* gain, const int* evcnt, const int* ev, const float* W2f) {
    const int gw = F.vcu * NWAVES + F.wave, NGW = F.G * NWAVES, lane = lane_id();
    for (int row = gw; row < M; row += NGW) {
        const GAS v4u* xr = (const GAS v4u*)(XB + (size_t)row * DM) + lane; GAS f32x4* orow = (GAS f32x4*)(out + (size_t)row * DM) + 2 * lane; const GAS f32x4* gr = (const GAS f32x4*)gain + 2 * lane;
        v4u x[8];
#pragma unroll
        for (int j = 0; j < 8; ++j) x[j] = xr[64 * j];
        int cnt = __builtin_amdgcn_readfirstlane(evcnt[row]); cnt = cnt < pg8::EV_MAX ? cnt : pg8::EV_MAX;
        f32x4 o0[8], o1[8];
#pragma unroll
        for (int j = 0; j < 8; ++j) { o0[j] = (f32x4){bflo(x[j].x), bfhi(x[j].x), bflo(x[j].y), bfhi(x[j].y)}; o1[j] = (f32x4){bflo(x[j].z), bfhi(x[j].z), bflo(x[j].w), bfhi(x[j].w)}; }
        if (cnt > 0) {
            const int ek = lane < cnt ? ev[((size_t)row * pg8::EV_MAX + lane) * 2] : 0x7fffffff; const float ee = lane < cnt ? __builtin_bit_cast(float, ev[((size_t)row * pg8::EV_MAX + lane) * 2 + 1]) : 0.f;
            int rank = 0;
#pragma unroll
            for (int j = 0; j < pg8::EV_MAX; ++j) rank += (__shfl(ek, j) < ek) ? 1 : 0;
            for (int a = 0; a < cnt; ++a) {
                const unsigned long long mask = __ballot(lane < cnt && rank == a); const int src = __builtin_ctzll(mask);
                const int k = __shfl(ek, src); const float e = __shfl(ee, src);
                const GAS f32x4* wr = (const GAS f32x4*)(W2f + (size_t)k * DM) + 2 * lane;
#pragma unroll
                for (int j = 0; j < 8; ++j) { const f32x4 w0 = wr[128 * j], w1 = wr[128 * j + 1]; o0[j] += w0 * e; o1[j] += w1 * e; }
            }
        }
        float s = 0.f;
#pragma unroll
        for (int j = 0; j < 8; ++j) s += (o0[j].x * o0[j].x + o0[j].y * o0[j].y) + (o0[j].z * o0[j].z + o0[j].w * o0[j].w) + (o1[j].x * o1[j].x + o1[j].y * o1[j].y) + (o1[j].z * o1[j].z + o1[j].w * o1[j].w);
        s = wave_sum(s);
        const float r = __builtin_amdgcn_rsqf(s * (1.0f / 4096.0f) + pg8::RMS_EPS);
#pragma unroll
        for (int j = 0; j < 8; ++j) { const f32x4 g0 = gr[128 * j], g1 = gr[128 * j + 1]; orow[128 * j] = o0[j] * r * g0; orow[128 * j + 1] = o1[j] * r * g1; }
    }
}

struct MemMaker { const bf16* Qsrc; int ldq, qcol0; const bf16* MKV; int l; bf16* Odst; int ldo, ocol0; unsigned char* Odst8;
    __device__ __forceinline__ AttnItem<256> operator()(int id) const {
        const int qt = id % (SEQ / 128), h = (id / (SEQ / 128)) % 4, b = id / (4 * (SEQ / 128));
        AttnItem<256> it;
        it.q = Qsrc + (size_t)(b * SEQ + 128 * qt) * ldq + qcol0 + h * 256; it.qstride = (size_t)ldq;
        it.k = MKV + (size_t)(b * MEMLEN) * DM + l * 2048 + h * 256; it.v = it.k + 1024; it.kstride = DM; it.key_lo = 0;
        it.o = Odst + (size_t)(b * SEQ + 128 * qt) * ldo + ocol0 + h * 256; it.ostride = (size_t)ldo; it.lse = nullptr; it.lse_stride = 0; it.bias = nullptr;
        it.o8 = Odst8 ? Odst8 + (size_t)(b * SEQ + 128 * qt) * ldo + ocol0 + h * 256 : nullptr;
        return it; } };
__device__ __forceinline__ void memattn_phase(Frame& F, const bf16* Qsrc, int ldq, int qcol0, const bf16* MKV, int l, bf16* Odst, int ldo, int ocol0, unsigned char* Odst8) {
    const MemMaker mk{Qsrc, ldq, qcol0, MKV, l, Odst, ldo, ocol0, Odst8};
    attn_run<256, false>(F.lds + RING_OFF, mk, F.vcu, F.G, BATCH * 4 * (SEQ / 128), F.wave);
}
struct DilMaker { const bf16* KVU; bf16* OG; float* LSE; const float* BT;
    __device__ __forceinline__ AttnItem<128> operator()(int id) const {
        const int j = id & 15, g = (id >> 4) % 3, h = ((id >> 4) / 3) & 7, b = (id >> 4) / 24;
        const int dil = g == 0 ? 1 : (g == 1 ? 4 : 16), r = g == 0 ? 0 : (g == 1 ? (j >> 2) : j), n = g == 0 ? j : (g == 1 ? (j & 3) : 0);
        AttnItem<128> it;
        const size_t rs = (size_t)dil * KVUW;
        const long row_q0 = (long)b * SEQ + (long)(128 * n) * dil + r;
        it.q = KVU + (size_t)row_q0 * KVUW + KVW + g * 1024 + h * 128; it.qstride = rs;
        const bf16* kq0 = KVU + (size_t)row_q0 * KVUW + g * 1024 + h * 128;
        it.k = kq0 - 128 * rs; it.v = it.k + 3072; it.kstride = rs; it.key_lo = n == 0 ? 128 : 0;
        it.o = OG + (size_t)g * M * 1024 + (size_t)row_q0 * 1024 + h * 128; it.ostride = (size_t)dil * 1024; it.o8 = nullptr;
        it.lse = LSE + (size_t)row_q0 * 24 + h * 3 + g; it.lse_stride = dil * 24; it.bias = BT + (g * 8 + h) * 129;
        return it; } };
__device__ __forceinline__ void dilattn_phase(Frame& F, const bf16* KVU, bf16* OG, float* LSE, const float* BT) {
    const DilMaker mk{KVU, OG, LSE, BT};
    attn_run<128, true>(F.lds + RING_OFF, mk, F.vcu, F.G, BATCH * 8 * 3 * 16, F.wave);
}

struct Args { const float* in[19]; float* out; unsigned char* ws; int ph_lo, ph_hi, li, pad; };
constexpr int N_STEPS = 14;
typedef const Args __attribute__((address_space(4))) CArgs;
__device__ __forceinline__ CArgs* kargs() { CArgs* p = (CArgs*)__builtin_amdgcn_kernarg_segment_ptr(); asm volatile("" : "+s"(p)); return p; }
#ifndef MK_ONLY
#define MK_ONLY -1
#endif
#define STEP_ON(k) (MK_ONLY < 0 || MK_ONLY == (k))

template <int L> __device__ __forceinline__ void step_inproj(Frame& F) {
    CArgs* ap = kargs(); unsigned char* ws = ap->ws;
    if constexpr (L == 0) {
        pg8::Gemm g; g.A = (const bf16*)(ws + WS_XB); g.Bt = (const bf16*)(ws + WS_WAIN); g.M = M; g.N = DM; g.K = DM; g.lda = DM; g.ldb = DM; g.npg = 0; g.a_gstride = 0;
        pg8::StaticOrder S; S.init(g.M, g.N, F.G, (int)blockIdx.x);
        pg8::EpiScaleBf16<0> E{nullptr, nullptr, (bf16*)(ws + WS_U), DM, (const pg8::ssq_t*)(ws + WS_SSQ0), 1.0f};
        pg8::gemm_phase<pg8::EpiScaleBf16<0>, pg8::StaticOrder, PG8_ALIGN, PG8_SP2>(F.lds + RING_OFF, g, S, E, F.wave);
    } else {
        pg8::Gemm g; g.A = (const bf16*)(ws + WS_XB8); g.Bt = (const bf16*)(ws + WS_WKVB); g.M = M; g.N = KVUW; g.K = DM / 2; g.lda = DM / 2; g.ldb = DM / 2; g.npg = 0; g.a_gstride = 0;
        pg8::StaticOrder S; S.init(g.M, g.N, F.G, (int)blockIdx.x);
        pg8::EpiScaleBf16<0, true> E{nullptr, nullptr, (bf16*)(ws + WS_KVU), KVUW, (const pg8::ssq_t*)(ws + WS_CTL + CTL_SS) + 1 * M, pg8::X2_RMS_RATIO / (pg8::I8_SA * pg8::I8_SW), (const pg8::ssq_t*)(ws + WS_CTL + CTL_SS) + 0 * M};
        pg8::gemm_phase<pg8::EpiScaleBf16<0, true>, pg8::StaticOrder, PG8_ALIGN, PG8_SP2, false, true>(F.lds + RING_OFF, g, S, E, F.wave);
    }
    const int Gh = F.G / 2;
    if (L == 0 && (int)blockIdx.x < Gh) {
        pg8::Gemm g; g.A = (const bf16*)(ws + WS_MEMB); g.Bt = (const bf16*)(ws + WS_WMEMKV); g.M = MMEM; g.N = DM; g.K = DM / 2; g.lda = DM / 2; g.ldb = DM / 2; g.npg = 0; g.a_gstride = 0;
        pg8::StaticOrder S; S.init(g.M, g.N, Gh, (int)blockIdx.x);
        pg8::EpiScaleBf16<0, true> E{nullptr, nullptr, (bf16*)(ws + WS_MKV), DM, nullptr, 1.0f / (pg8::I8_SA * pg8::I8_SW), nullptr};
        pg8::gemm_phase<pg8::EpiScaleBf16<0, true>, pg8::StaticOrder, PG8_ALIGN, PG8_SP2, false, true>(F.lds + RING_OFF, g, S, E, F.wave);
    }
    if (L == 0 && (int)blockIdx.x >= Gh) {
        pg8::Gemm g; g.A = (const bf16*)(ws + WS_WOUTP); g.Bt = (const bf16*)(ws + WS_WPG); g.M = DM; g.N = POOLW; g.K = POOLG; g.lda = POOLW; g.ldb = POOLG; g.npg = 3; g.a_gstride = POOLG * 2;
        pg8::StaticOrder S; S.init(g.M, g.N, F.G - Gh, (int)blockIdx.x - Gh);
        pg8::EpiScaleBf16<0> E{nullptr, nullptr, (bf16*)(ws + WS_WAOUT), DM, nullptr, 1.0f};
        pg8::gemm_phase<pg8::EpiScaleBf16<0>, pg8::StaticOrder, PG8_ALIGN, PG8_SP2>(F.lds + RING_OFF, g, S, E, F.wave);
    }
}
template <int L> __device__ __forceinline__ void step_mixer(Frame& F) {
    CArgs* ap = kargs(); unsigned char* ws = ap->ws;
    if (L == 0) {
        pool_phase(F, (const bf16*)(ws + WS_U), (bf16*)(ws + WS_CAT));
        memattn_phase(F, (const bf16*)(ws + WS_U), DM, POOLW, (const bf16*)(ws + WS_MKV), 0, (bf16*)(ws + WS_CAT), DM, POOLW, nullptr);
    } else {
        dilattn_phase(F, (const bf16*)(ws + WS_KVU), (bf16*)(ws + WS_OG), (float*)(ws + WS_LSE), (const float*)(ws + WS_SS0 + 131072));
        memattn_phase(F, (const bf16*)(ws + WS_KVU), KVUW, KVW + 3072, (const bf16*)(ws + WS_MKV), 1, nullptr, 2048, 1024, ws + WS_CAT2);
    }
}
template <int L> __device__ __forceinline__ void step_mix2(Frame& F) {
    CArgs* ap = kargs(); unsigned char* ws = ap->ws;
    if (L == 0) {
    } else {
        w2q_colsum_phase(F, ws + WS_W2 + (size_t)DM * DFF * 2, (int*)(ws + WS_SS0));
        merge_phase(F, (const bf16*)(ws + WS_OG), (const float*)(ws + WS_LSE), ws + WS_CAT2);
    }
}
template <int L> __device__ __forceinline__ void step_outproj(Frame& F) {
    CArgs* ap = kargs(); unsigned char* ws = ap->ws;
    pg8::StaticOrder S; S.init(M, DM, F.G, (int)blockIdx.x);
    if constexpr (L == 0) {
        pg8::Gemm g; g.A = (const bf16*)(ws + WS_CAT); g.Bt = (const bf16*)(ws + WS_WAOUT); g.M = M; g.N = DM; g.K = DM; g.lda = DM; g.ldb = DM; g.npg = 0; g.a_gstride = 0;
        pg8::EpiResid<2> E{(const bf16*)(ws + WS_XB), (bf16*)(ws + WS_XB), (pg8::ssq_t*)(ws + WS_CTL + CTL_SS) + 0 * M, ws + WS_XB8, 1.0f, (const pg8::ssq_t*)(ws + WS_SSQ0), pg8::I8_SA / pg8::X1_RMS_RATIO, nullptr};
        pg8::gemm_phase<pg8::EpiResid<2>, pg8::StaticOrder, PG8_ALIGN, PG8_SP2>(F.lds + RING_OFF, g, S, E, F.wave);
    } else {
        pg8::Gemm g; g.A = (const bf16*)(ws + WS_CAT2); g.Bt = (const bf16*)(ws + WS_WBOUT); g.M = M; g.N = DM; g.K = 1024; g.lda = 1024; g.ldb = 1024; g.npg = 0; g.a_gstride = 0;
        pg8::EpiResid<2> E{(const bf16*)(ws + WS_XB), (bf16*)(ws + WS_XB), (pg8::ssq_t*)(ws + WS_CTL + CTL_SS) + 2 * M, ws + WS_XB8, 1.0f / 1024.0f, (const pg8::ssq_t*)(ws + WS_CTL + CTL_SS) + 1 * M, pg8::I8_SA, nullptr};
        pg8::gemm_phase<pg8::EpiResid<2>, pg8::StaticOrder, PG8_ALIGN, PG8_SP2, true>(F.lds + RING_OFF, g, S, E, F.wave);
    }
}
template <int L> __device__ __forceinline__ void step_mlp1(Frame& F) {
    CArgs* ap = kargs(); unsigned char* ws = ap->ws;
    if constexpr (L == 0) {
    {
    pg8::Gemm g; g.A = (const bf16*)(ws + WS_XB8); g.Bt = (const bf16*)(ws + WS_W1); g.M = M; g.N = NQ0; g.K = DM / 2; g.lda = DM / 2; g.ldb = DM / 2; g.npg = 0; g.a_gstride = 0;
    pg8::StaticOrder S; S.init(g.M, g.N, F.G, (int)blockIdx.x);
    pg8::EpiScaleBf16<1, true> E{nullptr, nullptr, (bf16*)(ws + WS_HID), DFF, (const pg8::ssq_t*)(ws + WS_CTL + CTL_SS) + 0 * M, pg8::X1_RMS_RATIO / (pg8::I8_SA * pg8::I8_SW), (const pg8::ssq_t*)(ws + WS_SSQ0)};
    pg8::gemm_phase<pg8::EpiScaleBf16<1, true>, pg8::StaticOrder, PG8_ALIGN, PG8_SP2, false, true>(F.lds + RING_OFF, g, S, E, F.wave);
    }
    if constexpr (NQ0 < DFF) {
    pg8::Gemm g; g.A = (const bf16*)(ws + WS_XB); g.Bt = (const bf16*)(ws + WS_W1 + 64 * MiB); g.M = M; g.N = DFF - NQ0; g.K = DM; g.lda = DM; g.ldb = DM; g.npg = 0; g.a_gstride = 0;
    pg8::StaticOrder S; S.init(g.M, g.N, F.G, (int)blockIdx.x);
    pg8::EpiScaleBf16<1> E{nullptr, nullptr, (bf16*)(ws + WS_HID) + NQ0, DFF, (const pg8::ssq_t*)(ws + WS_CTL + CTL_SS) + 0 * M, 1.0f, nullptr};
    pg8::gemm_phase<pg8::EpiScaleBf16<1>, pg8::StaticOrder, PG8_ALIGN, PG8_SP2>(F.lds + RING_OFF, g, S, E, F.wave);
    }
    } else {
    pg8::Gemm g; g.A = (const bf16*)(ws + WS_XB8); g.Bt = (const bf16*)(ws + WS_W1) + (size_t)DFF * DM; g.M = M; g.N = DFF; g.K = DM / 2; g.lda = DM / 2; g.ldb = DM / 2; g.npg = 0; g.a_gstride = 0;
    pg8::StaticOrder S; S.init(g.M, g.N, F.G, (int)blockIdx.x);
    pg8::EpiScaleBf16<1, true, 1> E{(int*)(ws + WS_CTL + CTL_EVCNT), (int*)(ws + WS_EV), (bf16*)(ws + WS_HID), DFF, (const pg8::ssq_t*)(ws + WS_CTL + CTL_SS) + 2 * M, 1.0f / (pg8::I8_SA * pg8::I8_SW), (const pg8::ssq_t*)(ws + WS_CTL + CTL_SS) + 1 * M};
    pg8::gemm_phase<pg8::EpiScaleBf16<1, true, 1>, pg8::StaticOrder, PG8_ALIGN, PG8_SP2, false, true>(F.lds + RING_OFF, g, S, E, F.wave);
    }
}
template <int L> __device__ __forceinline__ void step_mlp2(Frame& F) {
    CArgs* ap = kargs(); unsigned char* ws = ap->ws;
    if constexpr (L == 0) {
    pg8::Gemm g; g.A = (const bf16*)(ws + WS_HID); g.Bt = (const bf16*)(ws + WS_W2); g.M = M; g.N = DM; g.K = DFF; g.lda = DFF; g.ldb = DFF; g.npg = 0; g.a_gstride = 0;
    pg8::StaticOrder S; S.init(g.M, g.N, F.G, (int)blockIdx.x);
    pg8::EpiResid<2> E{(const bf16*)(ws + WS_XB), (bf16*)(ws + WS_XB), (pg8::ssq_t*)(ws + WS_CTL + CTL_SS) + 1 * M, (unsigned char*)(ws + WS_XB8), 1.0f, (const pg8::ssq_t*)(ws + WS_CTL + CTL_SS) + 0 * M, pg8::I8_SA / pg8::X2_RMS_RATIO, nullptr};
    pg8::gemm_phase<pg8::EpiResid<2>, pg8::StaticOrder, PG8_ALIGN, PG8_SP2>(F.lds + RING_OFF, g, S, E, F.wave);
    } else {
    pg8::Gemm g; g.A = (const bf16*)(ws + WS_HID); g.Bt = (const bf16*)(ws + WS_W2) + (size_t)DM * DFF; g.M = M; g.N = DM; g.K = DFF / 2; g.lda = DFF / 2; g.ldb = DFF / 2; g.npg = 0; g.a_gstride = 0;
    pg8::StaticOrder S; S.init(g.M, g.N, F.G, (int)blockIdx.x);
    pg8::EpiResid<0, true> E{(const bf16*)(ws + WS_XB), (bf16*)(ws + WS_XB), (pg8::ssq_t*)(ws + WS_CTL + CTL_SS) + 3 * M, nullptr, pg8::HQ_R / (255.0f * pg8::I8_SW2), nullptr, 0.f, (const int*)(ws + WS_SS0)};
    pg8::gemm_phase<pg8::EpiResid<0, true>, pg8::StaticOrder, PG8_ALIGN, PG8_SP2, false, true>(F.lds + RING_OFF, g, S, E, F.wave);
    }
}

__global__ void __launch_bounds__(NWAVES * 64, 2) yoco_fwd(Args args) {
    extern __shared__ __attribute__((aligned(16))) unsigned char lds[];
    Frame F;
    F.lds = (LAS unsigned char*)lds;
    F.MISC = (volatile LAS unsigned*)(F.lds + MISC_OFF);
    F.wave = __builtin_amdgcn_readfirstlane((int)threadIdx.x >> 6);
    F.G = gridDim.x; { const int bx = blockIdx.x; F.vcu = (F.G % 8 == 0) ? (bx % 8) * (F.G / 8) + bx / 8 : bx; }
    F.ctl = (gu32*)(kargs()->ws + WS_CTL);
    for (int u = F.wave * 64 + lane_id(); u < (LDS_BYTES - LDSCTL_OFF) / 4; u += NWAVES * 64) ((LAS unsigned*)(F.lds + LDSCTL_OFF))[u] = 0u;
    __syncthreads();
    XcdBarrier bar; bar.bar = (unsigned*)(F.ctl + CW_BAR); bar.x = 0; bar.st = nullptr;
#define LEADER() (F.wave == 0 && lane_id() == 0)
    if (!MK_PER_PHASE) bar = xcd_barrier_post((unsigned*)(F.ctl + CW_BAR), F.MISC + 8, LEADER());
#define GRID_BAR() do { if (MK_PER_PHASE) { if (LEADER()) __hip_atomic_store(F.ctl + CW_TMO, 0xBADBA0u, RLX_AGENT); } else { xcd_barrier(bar, LEADER()); } } while (0)
#define LO (kargs()->ph_lo)
#define HI (kargs()->ph_hi)
#define IN(k) (STEP_ON(k) && LO <= (k) && (k) < HI)
#define SEAM(k) do { if (LO <= (k) && (k) + 1 < HI) GRID_BAR(); } while (0)

    if (IN(0)) { CArgs* ap = kargs(); Ptrs P;
        P.x = ap->in[0]; P.mem = ap->in[1]; P.a_norm = ap->in[2]; P.a_w_in = ap->in[3]; P.a_w_pg = ap->in[4]; P.a_scale = ap->in[5]; P.a_w_out = ap->in[6]; P.kv_norm = ap->in[7]; P.w_kv = ap->in[8];
        P.b_norm = ap->in[9]; P.b_w_in = ap->in[10]; P.b_w_out = ap->in[11]; P.mem_norm = ap->in[12]; P.w_mem_kv = ap->in[13]; P.mlp_norm = ap->in[14]; P.mlp_w1 = ap->in[15]; P.mlp_w2 = ap->in[16];
        P.rel_bias = ap->in[17]; P.final_norm = ap->in[18];
        p0_prologue(F, P, ap->ws); }
    SEAM(0);
    if (IN(1)) step_inproj<0>(F);
    SEAM(1);
    if (IN(2)) step_mixer<0>(F);
    SEAM(2);
    if (IN(4)) step_outproj<0>(F);
    SEAM(4);
    if (IN(5)) step_mlp1<0>(F);
    SEAM(5);
    if (IN(6)) step_mlp2<0>(F);
    SEAM(6);
    if (IN(7)) step_inproj<1>(F);
    SEAM(7);
    if (IN(8)) step_mixer<1>(F);
    SEAM(8);
    if (IN(9)) step_mix2<1>(F);
    SEAM(9);
    if (IN(10)) step_outproj<1>(F);
    SEAM(10);
    if (IN(11)) step_mlp1<1>(F);
    SEAM(11);
    if (IN(12)) step_mlp2<1>(F);
    SEAM(12);
    if (IN(13)) { CArgs* ap = kargs(); final_norm_phase(F, (const bf16*)(ap->ws + WS_XB), ap->out, ap->in[18], (const int*)(ap->ws + WS_CTL + CTL_EVCNT), (const int*)(ap->ws + WS_EV), ap->in[16] + (size_t)DFF * DM); }
#undef IN
#undef SEAM
}

extern "C" void kernel_launch(void* const* d_in, const int* in_sizes, int n_in, void* d_out, int out_size, void* d_ws, size_t ws_size, hipStream_t stream) {
    static int grid = 0;
    if (grid == 0) {
        if (n_in != 19 || in_sizes[0] != M * DM || out_size != M * DM || ws_size < WS_END) { fprintf(stderr, "kernel_launch: unexpected shapes (n_in %d, in0 %d, out %d, ws %zu); nothing launched\n", n_in, n_in > 0 ? in_sizes[0] : -1, out_size, ws_size); grid = -1; return; }
        int dev = 0, cus = 0, per_cu = 0;
        if (hipGetDevice(&dev) != hipSuccess || hipDeviceGetAttribute(&cus, hipDeviceAttributeMultiprocessorCount, dev) != hipSuccess) { fprintf(stderr, "kernel_launch: device query failed\n"); grid = -1; return; }
        if (hipFuncSetAttribute((const void*)yoco_fwd, hipFuncAttributeMaxDynamicSharedMemorySize, LDS_BYTES) != hipSuccess) { fprintf(stderr, "kernel_launch: hipFuncSetAttribute failed\n"); grid = -1; return; }
        if (hipOccupancyMaxActiveBlocksPerMultiprocessor(&per_cu, (const void*)yoco_fwd, NWAVES * 64, LDS_BYTES) != hipSuccess || per_cu < 1)
            fprintf(stderr, "kernel_launch: note: occupancy query reports %d workgroups per CU\n", per_cu);
        (void)hipGetLastError();
        grid = cus;
    }
    if (grid < 0) return;
    if (hipMemsetAsync((char*)d_ws + WS_CTL, 0, CTL_ZERO_BYTES, stream) != hipSuccess) { fprintf(stderr, "kernel_launch: memset failed\n"); return; }
    Args a{};
    for (int i = 0; i < 19; ++i) a.in[i] = (const float*)d_in[i];
    a.out = (float*)d_out; a.ws = (unsigned char*)d_ws;
#if MK_PER_PHASE
    for (int li = 0; li < N_STEPS; ++li) { a.ph_lo = li; a.ph_hi = li + 1; a.li = li;
        hipLaunchKernelGGL(yoco_fwd, dim3(grid), dim3(NWAVES * 64), LDS_BYTES, stream, a); }
#else
    a.ph_lo = 0; a.ph_hi = N_STEPS; a.li = 0;
    hipLaunchKernelGGL(yoco_fwd, dim3(grid), dim3(NWAVES * 64), LDS_BYTES, stream, a);
#endif
    const hipError_t le = hipPeekAtLastError();
    if (le != hipSuccess) fprintf(stderr, "kernel_launch: launch failed: %s\n", hipGetErrorName(le));
}
```

```cpp
#include <hip/hip_runtime.h>
#include <cstdio>
#include <cstdint>

#ifndef MK_PER_PHASE
#define MK_PER_PHASE 0
#endif

__device__ __forceinline__ int lane_id() { unsigned m = ~0u; asm volatile("" : "+s"(m)); return (int)__builtin_amdgcn_mbcnt_hi(m, __builtin_amdgcn_mbcnt_lo(m, 0u)); }
namespace pg8 {
#define PG8_LAS __attribute__((address_space(3)))
typedef unsigned short bf16_t;
typedef short bf16x8 __attribute__((ext_vector_type(8)));
typedef float f32x4 __attribute__((ext_vector_type(4)));
typedef unsigned u32x4 __attribute__((ext_vector_type(4)));
constexpr int BM = 256, BK = 64, HALF = 128, HTB = HALF * BK * 2  , STAGE_BYTES = 8 * HTB, NXCD = 8, WGM = 8;

__host__ __device__ __forceinline__ int lds_byte(int r, int c) { const int st = (r >> 4) * 2 + (c >> 5), rr = r & 15, cc = c & 31, ob = rr * 64 + cc * 2; return st * 1024 + (ob ^ (((ob >> 9) & 1) << 5)); }
__host__ __device__ __forceinline__ void stage_rc(int b, int& R, int& C) { const int st = b / 1024, sb = b % 1024, swz = sb ^ (((sb >> 9) & 1) << 5); R = (st >> 1) * 16 + swz / 64; C = (st & 1) * 32 + (swz % 64) / 2; }
__host__ __device__ __forceinline__ int perm32(int rho) { const int n = rho >> 4, i = rho & 15; return 8 * (i >> 2) + 4 * n + (i & 3); }

struct Unit { int pm, pn; };
struct Gemm { const bf16_t* A; const bf16_t* Bt; int M, N, K, lda, ldb, npg, a_gstride; };

struct StaticOrder {
    int nM, nN, nwg, G, c;
    __host__ __device__ void init(int M, int N, int G_, int c_) { nM = M / BM; nN = N / BM; nwg = nM * nN; G = G_; c = c_; }
    __host__ __device__ bool next(int i, Unit& u) const {
        const long L = (long)i * G + c; if (L >= nwg) return false;
        int wgid = (int)L; { const int q = nwg / NXCD, r = nwg % NXCD, xcd = wgid % NXCD, off = wgid / NXCD; wgid = (xcd < r ? xcd * (q + 1) : r * (q + 1) + (xcd - r) * q) + off; }
        const int nig = WGM * nN, gid = wgid / nig, fm = gid * WGM, gsz = (nM - fm) < WGM ? (nM - fm) : WGM;
        u.pm = fm + ((wgid % nig) % gsz); u.pn = (wgid % nig) / gsz; return true;
    }
    __device__ __forceinline__ void a_ready(const Unit&) const {}
    __device__ __forceinline__ void done(const Unit&) const {}
};

__device__ __forceinline__ unsigned cvt_pk_bf16(float lo, float hi) { unsigned r; asm volatile("v_cvt_pk_bf16_f32 %0, %1, %2" : "=v"(r) : "v"(lo), "v"(hi)); return r; }

constexpr float RMS_EPS = 1e-6f;
typedef unsigned long long ssq_t;
constexpr float SSQ_SCALE = 1048576.0f, SSQ_TO_MEAN = 1.0f / (1048576.0f * 4096.0f);
__device__ __forceinline__ ssq_t ssq_from(float s) { return (ssq_t)(s * SSQ_SCALE + 0.5f); }
__device__ __forceinline__ float rstd_of(ssq_t s) { return __builtin_amdgcn_rsqf((float)s * SSQ_TO_MEAN + RMS_EPS); }
typedef int i32x4 __attribute__((ext_vector_type(4)));
constexpr float I8_SW2 = 127.0f * 128.0f / 4.0f;
constexpr float I8_SW = 127.0f * 64.0f / 4.0f;
constexpr float I8_SA = 127.0f / 4.0f;
constexpr float X1_RMS_RATIO = 1.256f;
constexpr float X2_RMS_RATIO = 1.40f;
__device__ __forceinline__ float rms_of(ssq_t s) { return __builtin_sqrtf((float)s * SSQ_TO_MEAN + RMS_EPS); }
__device__ __forceinline__ unsigned q8(float v) { return (unsigned)(int)__builtin_rintf(__builtin_amdgcn_fmed3f(v, -127.0f, 127.0f)) & 255u; }
__device__ __forceinline__ unsigned pack_q8(float a, float b, float c, float d) { return q8(a) | (q8(b) << 8) | (q8(c) << 16) | (q8(d) << 24); }
constexpr int EV_MAX = 8;
constexpr float HQ_R = 17.0f;
template <int ACT, bool IACC = false, int OQ = 0> struct EpiScaleBf16 {
    static constexpr bool PERM = true, AFTER_DRAIN = false, CINIT = false;
    int* evcnt; int* ev;
    bf16_t* O; int ldc; const ssq_t* ss; float mul; const ssq_t* ssq;
    __device__ __forceinline__ void operator()(const f32x4 (&acc)[2][2][4][2], const Unit& u, int wr, int wc, int fr, int fq) const {
        const int row0 = u.pm * BM + wr * 64 + fr, col0 = u.pn * BM + wc * 32 + 8 * fq;
        float rs[2][4];
#pragma unroll
        for (int ai = 0; ai < 2; ++ai)
#pragma unroll
            for (int m = 0; m < 4; ++m) { rs[ai][m] = (ss ? rstd_of(ss[row0 + ai * HALF + m * 16]) : 1.0f) * mul;
                if constexpr (IACC) { if (ssq) rs[ai][m] *= rms_of(ssq[row0 + ai * HALF + m * 16]); } }
#pragma unroll
        for (int ai = 0; ai < 2; ++ai)
#pragma unroll
            for (int m = 0; m < 4; ++m) { bf16_t* rowp = O + (size_t)(row0 + ai * HALF + m * 16) * ldc + col0; const float r = rs[ai][m];
#pragma unroll
                for (int bj = 0; bj < 2; ++bj) { f32x4 v0, v1;
                    if constexpr (IACC) { const i32x4 i0 = __builtin_bit_cast(i32x4, acc[ai][bj][m][0]), i1 = __builtin_bit_cast(i32x4, acc[ai][bj][m][1]);
                        v0 = (f32x4){(float)i0[0], (float)i0[1], (float)i0[2], (float)i0[3]} * r; v1 = (f32x4){(float)i1[0], (float)i1[1], (float)i1[2], (float)i1[3]} * r; }
                    else { v0 = acc[ai][bj][m][0] * r; v1 = acc[ai][bj][m][1] * r; }
                    if (ACT == 1) {
#pragma unroll
                        for (int j = 0; j < 4; ++j) { const float a = fmaxf(v0[j], 0.f), b = fmaxf(v1[j], 0.f); v0[j] = a * a; v1[j] = b * b; } }
                    if constexpr (OQ == 1) { typedef unsigned v2u_t __attribute__((ext_vector_type(2))); constexpr float s = 255.0f / HQ_R;
#define PG8_HQ(v) ((unsigned)(int)__builtin_rintf(__builtin_fminf((v) * s, 255.0f)))
                        const unsigned q0 = (PG8_HQ(v0[0]) | (PG8_HQ(v0[1]) << 8) | (PG8_HQ(v0[2]) << 16) | (PG8_HQ(v0[3]) << 24)) ^ 0x80808080u;
                        const unsigned q1 = (PG8_HQ(v1[0]) | (PG8_HQ(v1[1]) << 8) | (PG8_HQ(v1[2]) << 16) | (PG8_HQ(v1[3]) << 24)) ^ 0x80808080u;
#undef PG8_HQ
                        *(v2u_t*)((unsigned char*)O + (size_t)(row0 + ai * HALF + m * 16) * ldc + col0 + bj * HALF) = (v2u_t){q0, q1};
                        const float vmx = fmaxf(fmaxf(fmaxf(v0[0], v0[1]), fmaxf(v0[2], v0[3])), fmaxf(fmaxf(v1[0], v1[1]), fmaxf(v1[2], v1[3])));
                        if (vmx > HQ_R) {
                            const int row = row0 + ai * HALF + m * 16;
#pragma unroll
                            for (int j = 0; j < 8; ++j) { const float v = j < 4 ? v0[j & 3] : v1[j & 3];
                                if (v > HQ_R) { const int idx = __hip_atomic_fetch_add(evcnt + row, 1, __ATOMIC_RELAXED, __HIP_MEMORY_SCOPE_AGENT);
                                    if (idx < EV_MAX) { typedef int v2i_t __attribute__((ext_vector_type(2))); *(v2i_t*)(ev + ((size_t)row * EV_MAX + idx) * 2) = (v2i_t){col0 + bj * HALF + j, __builtin_bit_cast(int, v - HQ_R)}; } } }
                        }
                    } else {
                    u32x4 w; w.x = cvt_pk_bf16(v0[0], v0[1]); w.y = cvt_pk_bf16(v0[2], v0[3]); w.z = cvt_pk_bf16(v1[0], v1[1]); w.w = cvt_pk_bf16(v1[2], v1[3]);
                    *(u32x4*)(rowp + bj * HALF) = w; } } }
    }
};
template <int XQ = 0, bool IACC = false> struct EpiResid {
    static constexpr bool PERM = true, AFTER_DRAIN = false, CINIT = IACC;
    const bf16_t* xin; bf16_t* xout; ssq_t* ss; unsigned char* x8; float mul; const ssq_t* qss; float qmul; const int* cs;
    __device__ __forceinline__ void init_acc(f32x4 (&acc)[2][2][4][2], const Unit& u, int wc, int fq) const {
#pragma unroll
        for (int bj = 0; bj < 2; ++bj)
#pragma unroll
            for (int n = 0; n < 2; ++n) { const i32x4 c = *(const i32x4*)(cs + u.pn * BM + bj * HALF + wc * 32 + 8 * fq + 4 * n);
#pragma unroll
                for (int ai = 0; ai < 2; ++ai)
#pragma unroll
                    for (int m = 0; m < 4; ++m) acc[ai][bj][m][n] = __builtin_bit_cast(f32x4, c); }
    }
    __device__ __forceinline__ void operator()(const f32x4 (&acc)[2][2][4][2], const Unit& u, int wr, int wc, int fr, int fq) const {
        const int row0 = u.pm * BM + wr * 64 + fr, col0 = u.pn * BM + wc * 32 + 8 * fq;
#pragma unroll
        for (int ai = 0; ai < 2; ++ai) {
            u32x4 xr[4][2];
#pragma unroll
            for (int m = 0; m < 4; ++m)
#pragma unroll
                for (int bj = 0; bj < 2; ++bj) xr[m][bj] = *(const u32x4*)(xin + (size_t)(row0 + ai * HALF + m * 16) * 4096 + col0 + bj * HALF);
#pragma unroll
            for (int m = 0; m < 4; ++m) { const int row = row0 + ai * HALF + m * 16; const size_t off = (size_t)row * 4096 + col0; float sq = 0.f;
                float qs = 0.f; if constexpr (XQ == 2) qs = rstd_of(qss[row]) * qmul;
#pragma unroll
                for (int bj = 0; bj < 2; ++bj) { const u32x4 x = xr[m][bj];
                    const f32x4 a0 = {__builtin_bit_cast(float, x.x << 16), __builtin_bit_cast(float, x.x & 0xffff0000u), __builtin_bit_cast(float, x.y << 16), __builtin_bit_cast(float, x.y & 0xffff0000u)};
                    const f32x4 a1 = {__builtin_bit_cast(float, x.z << 16), __builtin_bit_cast(float, x.z & 0xffff0000u), __builtin_bit_cast(float, x.w << 16), __builtin_bit_cast(float, x.w & 0xffff0000u)};
                    f32x4 c0, c1;
                    if constexpr (IACC) { const i32x4 i0 = __builtin_bit_cast(i32x4, acc[ai][bj][m][0]), i1 = __builtin_bit_cast(i32x4, acc[ai][bj][m][1]);
                        c0 = (f32x4){(float)i0[0], (float)i0[1], (float)i0[2], (float)i0[3]}; c1 = (f32x4){(float)i1[0], (float)i1[1], (float)i1[2], (float)i1[3]}; }
                    else { c0 = acc[ai][bj][m][0]; c1 = acc[ai][bj][m][1]; }
                    const f32x4 v0 = c0 * mul + a0, v1 = c1 * mul + a1;
                    u32x4 w; w.x = cvt_pk_bf16(v0[0], v0[1]); w.y = cvt_pk_bf16(v0[2], v0[3]); w.z = cvt_pk_bf16(v1[0], v1[1]); w.w = cvt_pk_bf16(v1[2], v1[3]); *(u32x4*)(xout + off + bj * HALF) = w;
                    if constexpr (XQ == 2) { typedef unsigned v2u_t __attribute__((ext_vector_type(2)));
                        *(v2u_t*)(x8 + off + bj * HALF) = (v2u_t){pack_q8(v0[0] * qs, v0[1] * qs, v0[2] * qs, v0[3] * qs), pack_q8(v1[0] * qs, v1[1] * qs, v1[2] * qs, v1[3] * qs)}; }
                    if constexpr (XQ == 1) { int p0 = __builtin_amdgcn_cvt_pk_fp8_f32(v0[0], v0[1], 0, false); p0 = __builtin_amdgcn_cvt_pk_fp8_f32(v0[2], v0[3], p0, true);
                        int p1 = __builtin_amdgcn_cvt_pk_fp8_f32(v1[0], v1[1], 0, false); p1 = __builtin_amdgcn_cvt_pk_fp8_f32(v1[2], v1[3], p1, true);
                        typedef int v2i_t __attribute__((ext_vector_type(2))); *(v2i_t*)(x8 + off + bj * HALF) = (v2i_t){p0, p1}; }
                    sq += (v0[0] * v0[0] + v0[1] * v0[1]) + (v0[2] * v0[2] + v0[3] * v0[3]) + (v1[0] * v1[0] + v1[1] * v1[1]) + (v1[2] * v1[2] + v1[3] * v1[3]); }
                sq += __shfl_xor(sq, 16); sq += __shfl_xor(sq, 32);
                if (fq == 0) __hip_atomic_fetch_add(ss + row, ssq_from(sq), __ATOMIC_RELAXED, __HIP_MEMORY_SCOPE_AGENT); }
            asm volatile("" ::: "memory");
        }
    }
};

typedef int v4i_t __attribute__((ext_vector_type(4)));
typedef int v8i_t __attribute__((ext_vector_type(8)));
__device__ __forceinline__ v8i_t cat8(const bf16x8 lo, const bf16x8 hi) { return __builtin_shufflevector(__builtin_bit_cast(v4i_t, lo), __builtin_bit_cast(v4i_t, hi), 0, 1, 2, 3, 4, 5, 6, 7); }
template <class Epi, class Sched, bool ALIGN_EPI = false, bool SP2 = false, bool F8 = false, bool I8 = false>
__device__ __forceinline__ void gemm_phase(PG8_LAS unsigned char* lds, const Gemm g, const Sched& S, const Epi& E, const int wid  ) {
    const int lane = lane_id(), tid = wid * 64 + lane, wr = wid >> 2, wc = wid & 3, fr = lane & 15, fq = lane >> 4;
    const int K = g.K, nt = K / BK;
    unsigned voffA[2], voffB[2];
#pragma unroll
    for (int i = 0; i < 2; ++i) { int R, C; stage_rc(tid * 16 + i * 8192, R, C); const int Rb = Epi::PERM ? ((R & ~31) + perm32(R & 31)) : R;
        voffA[i] = (unsigned)(R * g.lda + C) * 2u; voffB[i] = (unsigned)(Rb * g.ldb + C) * 2u; }
    const size_t kstep = (size_t)(BK * 2);
    const size_t hstepA = (size_t)HALF * g.lda * 2, hstepB = (size_t)HALF * g.ldb * 2;
    const size_t tstepA = 2 * hstepA, tstepB = 2 * hstepB;
    const unsigned ldsw = (unsigned)wid * 1024u;
    const int aoff = lds_byte(wr * 64 + fr, fq * 8), boff = lds_byte(wc * 32 + fr, fq * 8);
#define PG8_SA(b, h) (((b) * 2 + (h)) * HTB)
#define PG8_SB(b, h) ((4 + (b) * 2 + (h)) * HTB)
#define PG8_STAGE(bufoff, gbase, voff) do { _Pragma("unroll") for (int _i = 0; _i < 2; ++_i) \
        __builtin_amdgcn_global_load_lds((const unsigned*)((const char*)(gbase) + (voff)[_i]), (PG8_LAS unsigned*)(lds + (bufoff) + ldsw + _i * 8192), 16, 0, 0); } while (0)
#define PG8_LDA(dst, b, h) do { _Pragma("unroll") for (int m = 0; m < 4; ++m) { \
        if constexpr (F8) dst##8[m] = cat8(*(const PG8_LAS bf16x8*)(lds + PG8_SA(b, h) + aoff + m * 2048), *(const PG8_LAS bf16x8*)(lds + PG8_SA(b, h) + aoff + m * 2048 + 1024)); \
        else { _Pragma("unroll") for (int k = 0; k < 2; ++k) dst[m][k] = *(const PG8_LAS bf16x8*)(lds + PG8_SA(b, h) + aoff + m * 2048 + k * 1024); } } } while (0)
#define PG8_LDB(dst, b, h) do { _Pragma("unroll") for (int n = 0; n < 2; ++n) { \
        if constexpr (F8) dst##8[n] = cat8(*(const PG8_LAS bf16x8*)(lds + PG8_SB(b, h) + boff + n * 2048), *(const PG8_LAS bf16x8*)(lds + PG8_SB(b, h) + boff + n * 2048 + 1024)); \
        else { _Pragma("unroll") for (int k = 0; k < 2; ++k) dst[n][k] = *(const PG8_LAS bf16x8*)(lds + PG8_SB(b, h) + boff + n * 2048 + k * 1024); } } } while (0)
#define PG8_MMA(ai, bj, At, Bt) do { __builtin_amdgcn_s_setprio(1); \
        if constexpr (F8) { _Pragma("unroll") for (int m = 0; m < 4; ++m) _Pragma("unroll") for (int n = 0; n < 2; ++n) \
            asm volatile("v_mfma_scale_f32_16x16x128_f8f6f4 %0, %1, %2, %0, %3, %3 op_sel_hi:[0,0,0]" : "+v"(acc[ai][bj][m][n]) : "v"(Bt##8[n]), "v"(At##8[m]), "v"(one_scale)); } \
        else if constexpr (I8) { _Pragma("unroll") for (int m = 0; m < 4; ++m) _Pragma("unroll") for (int n = 0; n < 2; ++n) _Pragma("unroll") for (int k = 0; k < 2; ++k) \
            acc[ai][bj][m][n] = __builtin_bit_cast(f32x4, __builtin_amdgcn_mfma_i32_16x16x64_i8(__builtin_bit_cast(v4i_t, Bt[n][k]), __builtin_bit_cast(v4i_t, At[m][k]), __builtin_bit_cast(v4i_t, acc[ai][bj][m][n]), 0, 0, 0)); } \
        else { _Pragma("unroll") for (int m = 0; m < 4; ++m) _Pragma("unroll") for (int n = 0; n < 2; ++n) _Pragma("unroll") for (int k = 0; k < 2; ++k) \
            acc[ai][bj][m][n] = __builtin_amdgcn_mfma_f32_16x16x32_bf16(Bt[n][k], At[m][k], acc[ai][bj][m][n], 0, 0, 0); } \
        __builtin_amdgcn_s_setprio(0); } while (0)
#define PG8_WAIT_V(n) asm volatile("s_waitcnt vmcnt(" #n ")" ::: "memory")
#define PG8_WAIT_L(n) asm volatile("s_waitcnt lgkmcnt(" #n ")" ::: "memory")
#define PG8_BAR __builtin_amdgcn_s_barrier()
#define PG8_SCHED __builtin_amdgcn_sched_barrier(0)
#define PG8_ABASE(u) ((const char*)g.A + (size_t)(u).pm * tstepA + (g.npg ? (size_t)((u).pn / g.npg) * (size_t)g.a_gstride : (size_t)0))
    Unit cur, nxt; int ui = 0;
    if (!S.next(0, cur)) return;
    f32x4 acc[2][2][4][2];
    if constexpr (Epi::CINIT) E.init_acc(acc, cur, wc, fq);
    else {
#pragma unroll
    for (int a = 0; a < 2; ++a)
#pragma unroll
        for (int b = 0; b < 2; ++b)
#pragma unroll
            for (int m = 0; m < 4; ++m)
#pragma unroll
                for (int n = 0; n < 2; ++n) acc[a][b][m][n] = (f32x4){0.f, 0.f, 0.f, 0.f};
    }
    bf16x8 At[4][2], B0[2][2], B1[2][2];
    v8i_t At8[4], B08[2], B18[2];
    const int one_scale = 0x7F7F7F7F;
    const char* cA = PG8_ABASE(cur); const char* cB = (const char*)g.Bt + (size_t)cur.pn * tstepB;
    S.a_ready(cur);
    if constexpr (SP2) {
        PG8_STAGE(PG8_SB(0, 0), cB, voffB); PG8_STAGE(PG8_SB(0, 1), cB + hstepB, voffB); PG8_STAGE(PG8_SA(0, 0), cA, voffA); PG8_STAGE(PG8_SA(0, 1), cA + hstepA, voffA);
        if (wr == 1) PG8_BAR;
        PG8_WAIT_V(2); PG8_BAR;
        PG8_STAGE(PG8_SB(1, 0), cB + kstep, voffB); PG8_STAGE(PG8_SA(1, 0), cA + kstep, voffA); PG8_STAGE(PG8_SB(1, 1), cB + hstepB + kstep, voffB);
        PG8_WAIT_V(6); PG8_BAR;
    } else {
        PG8_STAGE(PG8_SB(0, 0), cB, voffB); PG8_STAGE(PG8_SA(0, 0), cA, voffA); PG8_STAGE(PG8_SB(0, 1), cB + hstepB, voffB); PG8_STAGE(PG8_SA(0, 1), cA + hstepA, voffA);
        if (wr == 1) PG8_BAR;
        PG8_WAIT_V(4); PG8_BAR;
        PG8_STAGE(PG8_SB(1, 0), cB + kstep, voffB); PG8_STAGE(PG8_SA(1, 0), cA + kstep, voffA); PG8_STAGE(PG8_SB(1, 1), cB + hstepB + kstep, voffB);
        PG8_WAIT_V(6); PG8_BAR;
    }
    for (;;) {
        const bool has_next = S.next(ui + 1, nxt);
        const char* nA = has_next ? PG8_ABASE(nxt) : cA; const char* nB = has_next ? (const char*)g.Bt + (size_t)nxt.pn * tstepB : cB;
        for (int t = 0; t < nt; t += 2) {
            const bool last = (t == nt - 2);
            const char* a1 = cA + (size_t)(t + 1) * kstep;
            const char* a2 = last ? nA : cA + (size_t)(t + 2) * kstep; const char* b2 = last ? nB : cB + (size_t)(t + 2) * kstep;
            const char* a3 = a2 + kstep; const char* b3 = b2 + kstep;
            if (last && has_next) S.a_ready(nxt);
            if constexpr (SP2) {
            PG8_LDB(B0, 0, 0); PG8_LDB(B1, 0, 1); PG8_SCHED; PG8_LDA(At, 0, 0); PG8_STAGE(PG8_SA(1, 1), a1 + hstepA, voffA);
            PG8_WAIT_V(8); PG8_WAIT_L(0); PG8_BAR; PG8_MMA(0, 0, At, B0); PG8_MMA(0, 1, At, B1); PG8_BAR; PG8_SCHED;
            PG8_LDA(At, 0, 1); PG8_STAGE(PG8_SB(0, 0), b2, voffB); PG8_STAGE(PG8_SB(0, 1), b2 + hstepB, voffB); PG8_STAGE(PG8_SA(0, 0), a2, voffA);
            PG8_WAIT_V(8); PG8_WAIT_L(0); PG8_BAR; PG8_MMA(1, 0, At, B0); PG8_MMA(1, 1, At, B1); PG8_BAR; PG8_SCHED;
            PG8_LDB(B0, 1, 0); PG8_LDB(B1, 1, 1); PG8_SCHED; PG8_LDA(At, 1, 0); PG8_STAGE(PG8_SA(0, 1), a2 + hstepA, voffA);
            PG8_WAIT_V(8); PG8_WAIT_L(0); PG8_BAR; PG8_MMA(0, 0, At, B0); PG8_MMA(0, 1, At, B1); PG8_BAR; PG8_SCHED;
            PG8_LDA(At, 1, 1); PG8_STAGE(PG8_SB(1, 0), b3, voffB); PG8_STAGE(PG8_SB(1, 1), b3 + hstepB, voffB); PG8_STAGE(PG8_SA(1, 0), a3, voffA);
            PG8_WAIT_V(8); PG8_WAIT_L(0); PG8_BAR; PG8_MMA(1, 0, At, B0); PG8_MMA(1, 1, At, B1); PG8_BAR; PG8_SCHED;
            } else {
            PG8_LDB(B0, 0, 0); PG8_SCHED; PG8_LDA(At, 0, 0); PG8_STAGE(PG8_SA(1, 1), a1 + hstepA, voffA);
            PG8_WAIT_L(8); PG8_BAR; PG8_WAIT_L(0); PG8_MMA(0, 0, At, B0); PG8_BAR; PG8_SCHED;
            PG8_LDB(B1, 0, 1); PG8_STAGE(PG8_SB(0, 0), b2, voffB);
            PG8_BAR; PG8_WAIT_L(0); PG8_MMA(0, 1, At, B1); PG8_BAR;
            PG8_LDA(At, 0, 1); PG8_STAGE(PG8_SA(0, 0), a2, voffA);
            PG8_BAR; PG8_WAIT_L(0); PG8_MMA(1, 0, At, B0); PG8_BAR; PG8_SCHED;
            PG8_STAGE(PG8_SB(0, 1), b2 + hstepB, voffB);
            PG8_WAIT_V(6); PG8_BAR; PG8_MMA(1, 1, At, B1); PG8_BAR;
            PG8_LDB(B0, 1, 0); PG8_SCHED; PG8_LDA(At, 1, 0); PG8_STAGE(PG8_SA(0, 1), a2 + hstepA, voffA);
            PG8_WAIT_L(8); PG8_BAR; PG8_WAIT_L(0); PG8_MMA(0, 0, At, B0); PG8_BAR; PG8_SCHED;
            PG8_LDB(B1, 1, 1); PG8_STAGE(PG8_SB(1, 0), b3, voffB);
            PG8_BAR; PG8_WAIT_L(0); PG8_MMA(0, 1, At, B1); PG8_BAR;
            PG8_LDA(At, 1, 1); PG8_STAGE(PG8_SA(1, 0), a3, voffA);
            PG8_BAR; PG8_WAIT_L(0); PG8_MMA(1, 0, At, B0); PG8_BAR; PG8_SCHED;
            PG8_STAGE(PG8_SB(1, 1), b3 + hstepB, voffB);
            PG8_WAIT_V(6); PG8_BAR; PG8_MMA(1, 1, At, B1); PG8_BAR;
            }
        }
        if constexpr (ALIGN_EPI) { if (wr == 0) PG8_BAR; }
        if constexpr (F8) asm volatile("s_nop 7\n\ts_nop 7\n\ts_nop 7" ::: "memory");
        if constexpr (!Epi::AFTER_DRAIN) { E(acc, cur, wr, wc, fr, fq); S.done(cur); }
        if (!has_next) break;
        if constexpr (Epi::CINIT) E.init_acc(acc, nxt, wc, fq);
        else {
#pragma unroll
        for (int a = 0; a < 2; ++a)
#pragma unroll
            for (int b = 0; b < 2; ++b)
#pragma unroll
                for (int m = 0; m < 4; ++m)
#pragma unroll
                    for (int n = 0; n < 2; ++n) acc[a][b][m][n] = (f32x4){0.f, 0.f, 0.f, 0.f};
        }
        cur = nxt; cA = nA; cB = nB; ++ui;
        if constexpr (ALIGN_EPI) { if (wr == 1) PG8_BAR; }
    }
    PG8_WAIT_V(0);
    if constexpr (!ALIGN_EPI) { if (wr == 0) PG8_BAR; }
    PG8_BAR;
#undef PG8_SA
#undef PG8_SB
#undef PG8_STAGE
#undef PG8_LDA
#undef PG8_LDB
#undef PG8_MMA
#undef PG8_WAIT_V
#undef PG8_WAIT_L
#undef PG8_BAR
#undef PG8_SCHED
#undef PG8_ABASE
}
}

#ifndef PG8_SP2
#define PG8_SP2 true
#endif
#ifndef PG8_ALIGN
#define PG8_ALIGN true
#endif

constexpr int NWAVES = 8;
constexpr int BATCH = 8, SEQ = 2048, DM = 4096, M = BATCH * SEQ, MEMLEN = 256, MMEM = BATCH * MEMLEN, DFF = 16384;
constexpr int POOLW = 3072, POOLG = 768, KVW = 6144, KVUW = 10240;
constexpr int NQ0 = 16384;

constexpr size_t MiB = 1u << 20;
constexpr size_t WS_CTL = 0, CTL_ZERO_BYTES = 1 * MiB;
constexpr size_t CTL_EVCNT = 768 * 1024;
constexpr size_t CTL_SS = 256 * 1024;
constexpr size_t WS_SS0 = 1 * MiB;
constexpr size_t WS_SSQ0 = 3 * MiB + 512 * 1024;
constexpr size_t WS_LSE = 2 * MiB;
constexpr size_t WS_EV = WS_LSE;
constexpr size_t WS_MKV = 4 * MiB;
constexpr size_t WS_MEMB = 20 * MiB;
constexpr size_t WS_WPG = 36 * MiB;
constexpr size_t WS_WAIN = 42 * MiB;
constexpr size_t WS_WMEMKV = 74 * MiB;
constexpr size_t WS_WAOUT = 106 * MiB;
constexpr size_t WS_XB8 = 900 * MiB;
constexpr size_t WS_WOUTP = 874 * MiB;
constexpr size_t WS_WKVB = 138 * MiB;
constexpr size_t WS_WBOUT = 218 * MiB;
constexpr size_t WS_W1 = 234 * MiB;
constexpr size_t WS_W2 = 490 * MiB;
constexpr size_t WS_XB = 746 * MiB;
constexpr size_t WS_X1 = 874 * MiB;
constexpr size_t WS_R = 1130 * MiB;
constexpr size_t WS_HID = WS_R;
constexpr size_t WS_U = WS_R, WS_POOLED = WS_R + 128 * MiB, WS_CAT = WS_R + 224 * MiB;
constexpr size_t WS_KVU = WS_R, WS_OG = WS_R + 320 * MiB, WS_CAT2 = WS_R + 416 * MiB;
constexpr size_t WS_END = 1642 * MiB;
constexpr int CW_TMO = 0, CW_CODE = 1, CW_BAR = 4096;

constexpr int RING_OFF = 0, RING_BYTES = 131072;
constexpr int LDSCTL_OFF = 143360, MISC_OFF = LDSCTL_OFF + 320;
constexpr int LDS_BYTES = 147456;

#define GAS __attribute__((address_space(1)))
#define LAS __attribute__((address_space(3)))
typedef unsigned short bf16;
typedef unsigned v4u __attribute__((ext_vector_type(4)));
typedef unsigned v2u __attribute__((ext_vector_type(2)));
typedef float f32x4 __attribute__((ext_vector_type(4)));
typedef short bf16x8 __attribute__((ext_vector_type(8)));
typedef short s16x4 __attribute__((ext_vector_type(4)));
typedef GAS unsigned gu32;
#define RLX_AGENT __ATOMIC_RELAXED, __HIP_MEMORY_SCOPE_AGENT
#define LDS_WAIT() asm volatile("s_waitcnt lgkmcnt(0)" ::: "memory")
#define VM_WAIT() asm volatile("s_waitcnt vmcnt(0)" ::: "memory")
__device__ __forceinline__ unsigned f2bf(float f) { unsigned u = __builtin_bit_cast(unsigned, f); return (u + 0x7fffu + ((u >> 16) & 1u)) >> 16; }
__device__ __forceinline__ unsigned pk2(float lo, float hi) { return f2bf(lo) | (f2bf(hi) << 16); }
__device__ __forceinline__ float bflo(unsigned w) { return __builtin_bit_cast(float, w << 16); }
__device__ __forceinline__ float bfhi(unsigned w) { return __builtin_bit_cast(float, w & 0xffff0000u); }

#define XB_TMO      128
#define XB_XCNT(j)  (256  + 64 * (j))
#define XB_XSUB(j)  (1280 + 64 * (j))
#define XB_XGEN(j)  (2304 + 64 * (j))
#define XB_TOP      3328
#define XB_TOPGEN   3392
#define XCD_BAR_WORDS 3456
#define XB_SPIN_CAP (1u << 22)
__device__ __forceinline__ unsigned xb_ld(unsigned* p)              { return __hip_atomic_load(p, __ATOMIC_RELAXED, __HIP_MEMORY_SCOPE_AGENT); }
__device__ __forceinline__ unsigned xb_add(unsigned* p, unsigned v) { return __hip_atomic_fetch_add(p, v, __ATOMIC_RELAXED, __HIP_MEMORY_SCOPE_AGENT); }
__device__ __forceinline__ unsigned xb_xcc_id() { return (unsigned)__builtin_amdgcn_s_getreg((3 << 11) | 20) & 0xFu; }
#define XB_SPIN(cond, bar) do { unsigned _sp = 0; while (cond) { __builtin_amdgcn_s_sleep(1); \
    if ((++_sp & 255u) == 0u) { if (xb_ld(&(bar)[XB_TMO])) break; if (_sp > XB_SPIN_CAP) { atomicAdd(&(bar)[XB_TMO], 1u); break; } } } } while (0)
struct XcdBarrier { unsigned* bar; unsigned x; volatile LAS unsigned* st; };
__device__ __forceinline__ XcdBarrier xcd_barrier_post(unsigned* bar, volatile LAS unsigned* st, bool leader  ) {
    XcdBarrier b; b.bar = bar; b.x = xb_xcc_id(); b.st = st;
    if (leader) (void)xb_add(&bar[XB_XCNT(b.x)], 1u);
    return b;
}
__device__ __forceinline__ void xcd_barrier_complete(unsigned* bar, unsigned x, unsigned& nloc, unsigned& nx) {
    const unsigned G = gridDim.x * gridDim.y * gridDim.z;
    unsigned sum, cnt, mine, sp = 0u;
    for (;;) {
        sum = 0u; cnt = 0u; mine = 0u;
#pragma unroll
        for (unsigned j = 0; j < 16; ++j) { const unsigned c = xb_ld(&bar[XB_XCNT(j)]); sum += c; cnt += (c > 0u) ? 1u : 0u; mine = (j == x) ? c : mine; }
        if (sum == G) break;
        __builtin_amdgcn_s_sleep(1);
        if ((++sp & 255u) == 0u) { if (xb_ld(&bar[XB_TMO])) break; if (sp > XB_SPIN_CAP) { atomicAdd(&bar[XB_TMO], 1u); break; } }
    }
    nloc = mine > 0u ? mine : 1u; nx = cnt > 0u ? cnt : 1u;
}
__device__ __forceinline__ void xcd_barrier(const XcdBarrier& b, bool leader  ) {
    asm volatile("s_waitcnt vmcnt(0)" ::: "memory");
    __syncthreads();
    if (leader) {
        unsigned* bar = b.bar;
        __builtin_amdgcn_s_waitcnt(0);
        unsigned nloc = b.st[0], nx = b.st[1];
        if (nloc == 0u) { xcd_barrier_complete(bar, b.x, nloc, nx); b.st[0] = nloc; b.st[1] = nx; }
        const unsigned old = xb_add(&bar[XB_XSUB(b.x)], 1u);
        const unsigned gen = old / nloc;
        if (old + 1u == (gen + 1u) * nloc) {
            __builtin_amdgcn_fence(__ATOMIC_RELEASE, "agent");
            asm volatile("s_waitcnt vmcnt(0)" ::: "memory");
            const unsigned og = xb_add(&bar[XB_TOP], 1u);
            const unsigned tg = og / nx;
            if (og + 1u == (tg + 1u) * nx) xb_add(&bar[XB_TOPGEN], 1u);
            else XB_SPIN(xb_ld(&bar[XB_TOPGEN]) == tg, bar);
            __builtin_amdgcn_fence(__ATOMIC_ACQUIRE, "agent");
            xb_add(&bar[XB_XGEN(b.x)], 1u);
            asm volatile("s_waitcnt vmcnt(0)" ::: "memory");
        } else {
            XB_SPIN(xb_ld(&bar[XB_XGEN(b.x)]) == gen, bar);
            __builtin_amdgcn_fence(__ATOMIC_ACQUIRE, "agent");
            asm volatile("s_waitcnt vmcnt(0)" ::: "memory");
        }
    }
    __syncthreads();
}

struct Frame {
    LAS unsigned char* lds;
    volatile LAS unsigned* MISC;
    gu32* ctl;
    int wave;
    int vcu, G;
};

__device__ __forceinline__ float wave_sum(float v) {
#pragma unroll
    for (int o = 1; o < 64; o <<= 1) v += __shfl_xor(v, o);
    return v;
}
template <int Q = 0>
__device__ __forceinline__ void p0_transpose_item(const float* W, int N, bf16* WT, int ldo, int row_off, const float* gk, const float* gn, LAS float* scr, int item, int lane, float qscale = pg8::I8_SW, int ncol = 0) {
    constexpr bool F8 = (Q != 0);
    const int nblk = (ncol ? ncol : N) / 64, kb = item / nblk, nb = item % nblk, n0 = 64 * nb;
    const int lr = lane >> 4, lq = lane & 15;
    const int c = lane & 7, nn = lane >> 3;
#pragma unroll 1
    for (int h = 0; h < (F8 ? 2 : 1); ++h) {
    const int k0 = F8 ? 128 * kb + 64 * h : 64 * kb;
    const float* src = W + (size_t)(k0 + lr) * N + n0 + 4 * lq;
    f32x4 v[16];
#pragma unroll
    for (int i = 0; i < 16; ++i) v[i] = *(const GAS f32x4*)(src + (size_t)(4 * i) * N);
    float gkv[8];
#pragma unroll
    for (int e = 0; e < 8; ++e) gkv[e] = gk ? gk[k0 + 8 * c + e] : 1.0f;
#pragma unroll
    for (int i = 0; i < 16; ++i) { LAS float* d = scr + (4 * i + lr) * 65 + 4 * lq; d[0] = v[i].x; d[1] = v[i].y; d[2] = v[i].z; d[3] = v[i].w; }
    LDS_WAIT(); asm volatile("" ::: "memory");
#pragma unroll
    for (int j = 0; j < 8; ++j) { const int n = 8 * j + nn; const LAS float* s = scr + (8 * c) * 65 + n; const float gg = (gn ? gn[n0 + n] : 1.0f) * (Q == 1 ? 64.0f : (Q == 2 ? qscale : 1.0f));
        if constexpr (Q == 2) {
            *(GAS v2u*)((unsigned char*)WT + (size_t)(row_off + n0 + n) * ldo + k0 + 8 * c) = (v2u){pg8::pack_q8(s[0 * 65] * gkv[0] * gg, s[1 * 65] * gkv[1] * gg, s[2 * 65] * gkv[2] * gg, s[3 * 65] * gkv[3] * gg),
                                                                                                      pg8::pack_q8(s[4 * 65] * gkv[4] * gg, s[5 * 65] * gkv[5] * gg, s[6 * 65] * gkv[6] * gg, s[7 * 65] * gkv[7] * gg)};
        } else if constexpr (Q == 1) {
            int p0 = __builtin_amdgcn_cvt_pk_fp8_f32(s[0 * 65] * gkv[0] * gg, s[1 * 65] * gkv[1] * gg, 0, false); p0 = __builtin_amdgcn_cvt_pk_fp8_f32(s[2 * 65] * gkv[2] * gg, s[3 * 65] * gkv[3] * gg, p0, true);
            int p1 = __builtin_amdgcn_cvt_pk_fp8_f32(s[4 * 65] * gkv[4] * gg, s[5 * 65] * gkv[5] * gg, 0, false); p1 = __builtin_amdgcn_cvt_pk_fp8_f32(s[6 * 65] * gkv[6] * gg, s[7 * 65] * gkv[7] * gg, p1, true);
            *(GAS v2u*)((unsigned char*)WT + (size_t)(row_off + n0 + n) * ldo + k0 + 8 * c) = (v2u){(unsigned)p0, (unsigned)p1};
        } else {
        v4u o; o.x = pk2(s[0 * 65] * gkv[0] * gg, s[1 * 65] * gkv[1] * gg); o.y = pk2(s[2 * 65] * gkv[2] * gg, s[3 * 65] * gkv[3] * gg);
        o.z = pk2(s[4 * 65] * gkv[4] * gg, s[5 * 65] * gkv[5] * gg); o.w = pk2(s[6 * 65] * gkv[6] * gg, s[7 * 65] * gkv[7] * gg);
        *(GAS v4u*)(WT + (size_t)(row_off + n0 + n) * ldo + k0 + 8 * c) = o; } }
    LDS_WAIT(); asm volatile("" ::: "memory");
    }
}
__device__ __forceinline__ void row_to_bf16_ss(int lane, const float* xrow, bf16* orow, pg8::ssq_t* ssp) {
    const GAS f32x4* xr = (const GAS f32x4*)xrow + lane;
    GAS unsigned long long* o8 = (GAS unsigned long long*)orow + lane;
    float s = 0.f;
#pragma unroll
    for (int j = 0; j < 16; ++j) { const f32x4 v = xr[64 * j]; s += (v.x * v.x + v.y * v.y) + (v.z * v.z + v.w * v.w);
        o8[64 * j] = (unsigned long long)pk2(v.x, v.y) | ((unsigned long long)pk2(v.z, v.w) << 32); }
    s = wave_sum(s);
    if (lane == 0) *ssp = pg8::ssq_from(s);
}

__device__ __forceinline__ void row_to_q8(int lane, const float* xrow, unsigned char* qrow) {
    const GAS f32x4* xr = (const GAS f32x4*)xrow + lane;
    f32x4 v[16]; float s = 0.f;
#pragma unroll
    for (int j = 0; j < 16; ++j) { v[j] = xr[64 * j]; s += (v[j].x * v[j].x + v[j].y * v[j].y) + (v[j].z * v[j].z + v[j].w * v[j].w); }
    s = wave_sum(s);
    const float r = pg8::rstd_of(pg8::ssq_from(s)) * pg8::I8_SA; GAS unsigned* q = (GAS unsigned*)qrow + lane;
#pragma unroll
    for (int j = 0; j < 16; ++j) q[64 * j] = pg8::pack_q8(v[j].x * r, v[j].y * r, v[j].z * r, v[j].w * r);
}

struct Ptrs {
    const float *x, *mem, *a_norm, *a_w_in, *a_w_pg, *a_scale, *a_w_out, *kv_norm, *w_kv, *b_norm, *b_w_in, *b_w_out, *mem_norm, *w_mem_kv, *mlp_norm, *mlp_w1, *mlp_w2, *rel_bias, *final_norm;
};

__device__ __forceinline__ void p0_prologue(Frame& F, const Ptrs& P, unsigned char* ws) {
    const int lane = lane_id(), tid = F.wave * 64 + lane;
    LAS float* scr = (LAS float*)(F.lds + RING_OFF + F.wave * 16640);
    const int gw = F.vcu * NWAVES + F.wave, NGW = F.G * NWAVES;
    bf16* WAIN = (bf16*)(ws + WS_WAIN); bf16* WMEMKV = (bf16*)(ws + WS_WMEMKV); bf16* WPG = (bf16*)(ws + WS_WPG); bf16* WAOUT = (bf16*)(ws + WS_WAOUT);
    bf16* WKVB = (bf16*)(ws + WS_WKVB); bf16* WBOUT = (bf16*)(ws + WS_WBOUT); bf16* W1 = (bf16*)(ws + WS_W1); bf16* W2 = (bf16*)(ws + WS_W2);
    constexpr int I_SQ = (DM / 64) * (DM / 64);
    constexpr int I_MKV = (DM / 128) * (2048 / 64);
    constexpr int I_PG = (POOLG / 64) * (POOLG / 64);
    constexpr int I_W2 = (DFF / 64) * (DM / 64);
    constexpr int I_KV = (DM / 128) * (KVW / 64);
    constexpr int I_BIN = (DM / 128) * (DM / 64);
    constexpr int I_BO = (2048 / 128) * (DM / 64);
    constexpr int I_W1Q = (DM / 128) * (DFF / 64);
    constexpr int I_W2Q = (DFF / 128) * (DM / 64);
    constexpr int I_W1A = (DM / 128) * (NQ0 / 64), I_W1B = (DM / 64) * ((DFF - NQ0) / 64);
    constexpr int NITEMS = 2 * I_SQ + I_BIN + 2 * I_MKV + I_W1A + I_W1B + I_W1Q + I_W2 + I_W2Q + I_KV + I_BO;
    for (int it = gw; it < NITEMS; it += NGW) {
        int r = it;
        if (r < I_W1A) { p0_transpose_item<2>(P.mlp_w1, DFF, W1, DM, 0, P.mlp_norm, nullptr, scr, r, lane, pg8::I8_SW, NQ0); continue; } r -= I_W1A;
        if (r < I_W1B) { p0_transpose_item(P.mlp_w1 + NQ0, DFF, W1 + (size_t)32 * 1024 * 1024, DM, 0, P.mlp_norm, nullptr, scr, r, lane, 1.0f, DFF - NQ0); continue; } r -= I_W1B;
        if (r < I_W1Q) { p0_transpose_item<2>(P.mlp_w1 + (size_t)DM * DFF, DFF, W1 + (size_t)DFF * DM, DM, 0, P.mlp_norm + DM, nullptr, scr, r, lane); continue; } r -= I_W1Q;
        if (r < I_W2) { p0_transpose_item(P.mlp_w2, DM, W2, DFF, 0, nullptr, nullptr, scr, r, lane); continue; } r -= I_W2;
        if (r < I_W2Q) { p0_transpose_item<2>(P.mlp_w2 + (size_t)DFF * DM, DM, W2 + (size_t)DM * DFF, DFF, 0, nullptr, nullptr, scr, r, lane, pg8::I8_SW2); continue; } r -= I_W2Q;
        if (r < I_KV) { p0_transpose_item<2>(P.w_kv, KVW, WKVB, DM, 0, P.kv_norm, nullptr, scr, r, lane); continue; } r -= I_KV;
        if (r < I_BIN) { p0_transpose_item<2>(P.b_w_in, DM, WKVB, DM, KVW, P.b_norm, nullptr, scr, r, lane); continue; } r -= I_BIN;
        if (r < I_SQ) { p0_transpose_item(P.a_w_in, DM, WAIN, DM, 0, P.a_norm, nullptr, scr, r, lane); continue; } r -= I_SQ;
        if (r < I_SQ) { const bool poolrows = (r / (DM / 64)) * 64 < POOLW;
            p0_transpose_item(P.a_w_out, DM, poolrows ? (bf16*)(ws + WS_WOUTP) : WAOUT, poolrows ? POOLW : DM, 0, nullptr, nullptr, scr, r, lane); continue; } r -= I_SQ;
        if (r < 2 * I_MKV) { const int l = r / I_MKV; r -= l * I_MKV; p0_transpose_item<2>(P.w_mem_kv + (size_t)l * DM * 2048, 2048, WMEMKV, DM, l * 2048, P.mem_norm, nullptr, scr, r, lane); continue; } r -= 2 * I_MKV;
        p0_transpose_item<1>(P.b_w_out, DM, WBOUT, 2048, 0, nullptr, nullptr, scr, r, lane);
    }
    bf16* XB = (bf16*)(ws + WS_XB); pg8::ssq_t* ss0 = (pg8::ssq_t*)(ws + WS_SSQ0);
    for (int m = gw; m < M + MMEM + POOLW; m += NGW) {
        if (m < M) row_to_bf16_ss(lane, P.x + (size_t)m * DM, XB + (size_t)m * DM, ss0 + m);
        else if (m < M + MMEM) { const int mm = m - M; row_to_q8(lane, P.mem + (size_t)mm * DM, ws + WS_MEMB + (size_t)mm * DM); }
        else { const int rr = m - M - MMEM, g = rr / POOLG;
            const GAS f32x4* wr_ = (const GAS f32x4*)(P.a_w_pg + (size_t)rr * POOLG) + lane; const GAS f32x4* sc = (const GAS f32x4*)(P.a_scale + g * POOLG) + lane;
            GAS unsigned long long* o8 = (GAS unsigned long long*)(WPG + (size_t)rr * POOLG) + lane;
#pragma unroll
            for (int j = 0; j < 3; ++j) { const f32x4 v = wr_[64 * j] * sc[64 * j]; o8[64 * j] = (unsigned long long)pk2(v.x, v.y) | ((unsigned long long)pk2(v.z, v.w) << 32); } }
    }
    float* BT = (float*)(ws + WS_SS0 + 131072);
    for (int i = (int)blockIdx.x * 512 + tid; i < 24 * 129; i += F.G * 512) {
        const int gh = i / 129, delta = i % 129, g = gh >> 3, dil = g == 0 ? 1 : (g == 1 ? 4 : 16), dist = delta * dil;
        int bucket = dist;
        if (dist >= 16) { const float d32 = (float)dist; int lg = 16 + (int)(logf(d32 / 16.0f) / 4.852030263919617f * 16.0f); bucket = lg < 31 ? lg : 31; }
        BT[i] = P.rel_bias[bucket * 24 + gh];
    }
}

template <int D> struct AttnItem {
    const bf16* q; size_t qstride;
    const bf16* k; const bf16* v; size_t kstride;
    int key_lo;
    bf16* o; size_t ostride;
    unsigned char* o8;
    float* lse; int lse_stride;
    const float* bias;
};
#define ATT_WAIT0() asm volatile("s_waitcnt vmcnt(0) lgkmcnt(0)" ::: "memory")
template <int OFF> __device__ __forceinline__ s16x4 att_tr_read(unsigned vb) { s16x4 r; asm volatile("ds_read_b64_tr_b16 %0, %1 offset:%2" : "=&v"(r) : "v"(vb), "i"(OFF) : "memory"); return r; }
template <int D, int S, int DB0> __device__ __forceinline__ void att_pv4(f32x4 (&oacc)[D / 16], const unsigned (&vb)[D / 16], const bf16x8 p) {
    constexpr int HIOFF = (D == 256 && S >= 4) ? 65536 : 0, OFF0 = (32 * S) * (2 * D) - HIOFF, OFF1 = OFF0 + 16 * (2 * D);
    const s16x4 a0 = att_tr_read<OFF0>(vb[DB0 + 0] + HIOFF), a1 = att_tr_read<OFF1>(vb[DB0 + 0] + HIOFF), b0 = att_tr_read<OFF0>(vb[DB0 + 1] + HIOFF), b1 = att_tr_read<OFF1>(vb[DB0 + 1] + HIOFF);
    const s16x4 c0 = att_tr_read<OFF0>(vb[DB0 + 2] + HIOFF), c1 = att_tr_read<OFF1>(vb[DB0 + 2] + HIOFF), d0 = att_tr_read<OFF0>(vb[DB0 + 3] + HIOFF), d1 = att_tr_read<OFF1>(vb[DB0 + 3] + HIOFF);
    asm volatile("s_waitcnt lgkmcnt(0)" ::: "memory"); __builtin_amdgcn_sched_barrier(0);
    oacc[DB0 + 0] = __builtin_amdgcn_mfma_f32_16x16x32_bf16(__builtin_shufflevector(a0, a1, 0, 1, 2, 3, 4, 5, 6, 7), p, oacc[DB0 + 0], 0, 0, 0);
    oacc[DB0 + 1] = __builtin_amdgcn_mfma_f32_16x16x32_bf16(__builtin_shufflevector(b0, b1, 0, 1, 2, 3, 4, 5, 6, 7), p, oacc[DB0 + 1], 0, 0, 0);
    oacc[DB0 + 2] = __builtin_amdgcn_mfma_f32_16x16x32_bf16(__builtin_shufflevector(c0, c1, 0, 1, 2, 3, 4, 5, 6, 7), p, oacc[DB0 + 2], 0, 0, 0);
    oacc[DB0 + 3] = __builtin_amdgcn_mfma_f32_16x16x32_bf16(__builtin_shufflevector(d0, d1, 0, 1, 2, 3, 4, 5, 6, 7), p, oacc[DB0 + 3], 0, 0, 0);
}
template <int D, int S> __device__ __forceinline__ void att_pv_step(f32x4 (&oacc)[D / 16], const unsigned (&vb)[D / 16], const bf16x8 p) {
    att_pv4<D, S, 0>(oacc, vb, p); att_pv4<D, S, 4>(oacc, vb, p);
    if constexpr (D == 256) { att_pv4<D, S, 8>(oacc, vb, p); att_pv4<D, S, 12>(oacc, vb, p); }
}
#define ATT_BAR() do { asm volatile("" ::: "memory"); __builtin_amdgcn_s_barrier(); asm volatile("" ::: "memory"); } while (0)
template <int D, bool DIL, class Maker>
__device__ __forceinline__ void attn_run(LAS unsigned char* lds, const Maker& mk, int first, int stride, int nitems, const int w  ) {
    const int lane = lane_id(), tid = w * 64 + lane;
    constexpr int NDC = D / 64, NKB = 2 * NDC, NV = D / 16, CPR = D / 8, RPB = 64 / CPR;
    constexpr int KOFF = 0, VOFF = (D == 128) ? 65536 : 0, BTOFF = 131072;
    if (first >= nitems) return;
    const int g = lane >> 4, c = lane & 15;
    LAS float* bt = (LAS float*)(lds + BTOFF);
    int Rk[2], Ck[2];
#pragma unroll
    for (int i = 0; i < 2; ++i) pg8::stage_rc(tid * 16 + i * 8192, Rk[i], Ck[i]);
    const int vrow = lane / CPR, vpos = lane % CPR;
    const int q4 = c >> 2, p4 = c & 3, sw3 = 4 * (g & 1) + q4;
    const unsigned vlane = VOFF + (4 * g + q4) * (2 * D) + 8 * (p4 & 1) + 16 * (p4 >> 1);
    const unsigned klane = KOFF + pg8::lds_byte(c, 8 * g);
    const unsigned ldsbase = (unsigned)(size_t)lds;
    bf16x8 qf[D / 32];
    f32x4 sacc[16];
    f32x4 oacc[D / 16];
    bf16x8 pf[8];
    float rl = 1.f, rm = 0.f;
#define ATT_ISSUE_K(it) do { int wv = w; asm volatile("" : "+s"(wv)); _Pragma("unroll") for (int hb = 0; hb < NKB; ++hb) { _Pragma("unroll") for (int i = 0; i < 2; ++i) { int row = (hb / NDC) * 128 + Rk[i]; row = row < (it).key_lo ? (it).key_lo : row; \
        __builtin_amdgcn_global_load_lds((const unsigned*)((it).k + (size_t)row * (it).kstride + (hb % NDC) * 64 + Ck[i]), (LAS unsigned*)(lds + KOFF + hb * 16384 + i * 8192 + wv * 1024), 16, 0, 0); } } } while (0)
#define ATT_ISSUE_V(it) do { int wv = w; asm volatile("" : "+s"(wv)); _Pragma("unroll") for (int j = 0; j < NV; ++j) { const int row = (j * 8 + wv) * RPB + vrow; const int rowc = row < (it).key_lo ? (it).key_lo : row; const int ch = vpos ^ ((row & 7) << 1); \
        __builtin_amdgcn_global_load_lds((const unsigned*)((it).v + (size_t)rowc * (it).kstride + 8 * ch), (LAS unsigned*)(lds + VOFF + (j * 8 + wv) * 1024), 16, 0, 0); } } while (0)
#define ATT_LOAD_Q(it) do { const bf16* qp = (it).q + (size_t)(16 * w + c) * (it).qstride + 8 * g; _Pragma("unroll") for (int s = 0; s < D / 32; ++s) qf[s] = *(const GAS bf16x8*)(qp + 32 * s); } while (0)
#define ATT_S_SOFTMAX(it) do { int wv = w; asm volatile("" : "+s"(wv)); \
    const int kb_lo = DIL ? (wv > ((it).key_lo >> 4) ? wv : ((it).key_lo >> 4)) : 0, kb_hi = DIL ? wv + 8 : 15; \
    _Pragma("unroll") for (int kb = 0; kb < 16; ++kb) sacc[kb] = (f32x4){0.f, 0.f, 0.f, 0.f}; \
    _Pragma("unroll") for (int kb = 0; kb < 16; ++kb) { if (kb >= kb_lo && kb <= kb_hi) { \
        _Pragma("unroll") for (int s = 0; s < D / 32; ++s) { \
            const bf16x8 kf = *(const LAS bf16x8*)(lds + klane + ((kb >> 3) * NDC + (s >> 1)) * 16384 + ((kb & 7) * 2 + (s & 1)) * 1024); \
            sacc[kb] = __builtin_amdgcn_mfma_f32_16x16x32_bf16(kf, qf[s], sacc[kb], 0, 0, 0); } } } \
    const float scale = DIL ? 0.08838834764831845f : 0.0625f; int ql = 16 * wv + c; asm volatile("" : "+v"(ql)); float mx = -3.0e38f; \
    _Pragma("unroll") for (int kb = 0; kb < 16; ++kb) { _Pragma("unroll") for (int r = 0; r < 4; ++r) { float lg; \
        if (DIL) { const int kl = 16 * kb + 4 * g + r, delta = ql + 128 - kl; const bool ok = (kb >= kb_lo) && (kb <= kb_hi) && delta >= 0 && delta <= 128 && kl >= (it).key_lo; \
            const int di = delta < 0 ? 0 : (delta > 128 ? 128 : delta); lg = ok ? sacc[kb][r] * scale + bt[di] : -3.0e38f; } \
        else lg = sacc[kb][r] * scale; \
        sacc[kb][r] = lg; mx = fmaxf(mx, lg); } } \
    mx = fmaxf(mx, __shfl_xor(mx, 16)); mx = fmaxf(mx, __shfl_xor(mx, 32)); float sum = 0.f; \
    _Pragma("unroll") for (int kb = 0; kb < 16; ++kb) { _Pragma("unroll") for (int r = 0; r < 4; ++r) { const float lg = sacc[kb][r]; const float p = lg > -1.0e38f ? __expf(lg - mx) : 0.f; sacc[kb][r] = p; sum += p; } } \
    sum += __shfl_xor(sum, 16); sum += __shfl_xor(sum, 32); rl = sum; rm = mx; \
    _Pragma("unroll") for (int s = 0; s < 8; ++s) { v4u pw; pw.x = pk2(sacc[2 * s][0], sacc[2 * s][1]); pw.y = pk2(sacc[2 * s][2], sacc[2 * s][3]); pw.z = pk2(sacc[2 * s + 1][0], sacc[2 * s + 1][1]); pw.w = pk2(sacc[2 * s + 1][2], sacc[2 * s + 1][3]); \
        pf[s] = __builtin_bit_cast(bf16x8, pw); } } while (0)
#define ATT_PV_STORE(it) do { int wv = w; asm volatile("" : "+s"(wv)); \
    const int kb_lo = DIL ? (wv > ((it).key_lo >> 4) ? wv : ((it).key_lo >> 4)) : 0, kb_hi = DIL ? wv + 8 : 15; \
    _Pragma("unroll") for (int i = 0; i < D / 16; ++i) oacc[i] = (f32x4){0.f, 0.f, 0.f, 0.f}; \
    unsigned vb[D / 16]; _Pragma("unroll") for (int db = 0; db < D / 16; ++db) vb[db] = ldsbase + vlane + 32 * (db ^ sw3); \
    if (1 >= kb_lo && 0 <= kb_hi) att_pv_step<D, 0>(oacc, vb, pf[0]); \
    if (3 >= kb_lo && 2 <= kb_hi) att_pv_step<D, 1>(oacc, vb, pf[1]); \
    if (5 >= kb_lo && 4 <= kb_hi) att_pv_step<D, 2>(oacc, vb, pf[2]); \
    if (7 >= kb_lo && 6 <= kb_hi) att_pv_step<D, 3>(oacc, vb, pf[3]); \
    if (9 >= kb_lo && 8 <= kb_hi) att_pv_step<D, 4>(oacc, vb, pf[4]); \
    if (11 >= kb_lo && 10 <= kb_hi) att_pv_step<D, 5>(oacc, vb, pf[5]); \
    if (13 >= kb_lo && 12 <= kb_hi) att_pv_step<D, 6>(oacc, vb, pf[6]); \
    if (15 >= kb_lo && 14 <= kb_hi) att_pv_step<D, 7>(oacc, vb, pf[7]); \
    const float inv = 1.0f / rl; bf16* op = (it).o + (size_t)(16 * w + c) * (it).ostride + 4 * g; \
    if ((it).o8) { const float inv16 = inv * 16.0f; unsigned char* op8 = (it).o8 + (size_t)(16 * w + c) * (it).ostride + 4 * g; \
        _Pragma("unroll") for (int db = 0; db < D / 16; ++db) { int p = __builtin_amdgcn_cvt_pk_fp8_f32(oacc[db][0] * inv16, oacc[db][1] * inv16, 0, false); p = __builtin_amdgcn_cvt_pk_fp8_f32(oacc[db][2] * inv16, oacc[db][3] * inv16, p, true); *(GAS int*)(op8 + 16 * db) = p; } } \
    else { _Pragma("unroll") for (int db = 0; db < D / 16; ++db) { v2u o2; o2.x = pk2(oacc[db][0] * inv, oacc[db][1] * inv); o2.y = pk2(oacc[db][2] * inv, oacc[db][3] * inv); *(GAS v2u*)(op + 16 * db) = o2; } } \
    if (DIL) { if (g == 0) (it).lse[(size_t)(16 * w + c) * (it).lse_stride] = rm + __logf(rl); } } while (0)

#define ATT_QFENCE() do { _Pragma("unroll") for (int s = 0; s < D / 32; ++s) asm volatile("" :: "v"(qf[s])); } while (0)
#define ATT_ITEM(idv) ([&]() { int _i = (idv); asm volatile("" : "+s"(_i)); return mk(_i); }())
    if constexpr (D == 128) {
        int id = first;
        { const AttnItem<D> it = ATT_ITEM(id); ATT_ISSUE_K(it); ATT_LOAD_Q(it); }
        for (;;) {
            { const AttnItem<D> it = ATT_ITEM(id);
              if (DIL) { if (tid < 129) bt[tid] = it.bias[tid]; }
              ATT_WAIT0(); ATT_QFENCE(); ATT_BAR();
              ATT_ISSUE_V(it); }
            { const AttnItem<D> it = ATT_ITEM(id); ATT_S_SOFTMAX(it); }
            ATT_WAIT0(); ATT_BAR();
            const int nid = id + stride; const bool has_next = nid < nitems;
            if (has_next) { const AttnItem<D> it = ATT_ITEM(nid); ATT_ISSUE_K(it); ATT_LOAD_Q(it); }
            { const AttnItem<D> it = ATT_ITEM(id); ATT_PV_STORE(it); }
            if (!has_next) break;
            id = nid;
        }
    } else {
        for (int id = first; id < nitems; id += stride) {
            { const AttnItem<D> it = ATT_ITEM(id); ATT_ISSUE_K(it); ATT_LOAD_Q(it); }
            ATT_WAIT0(); ATT_QFENCE(); ATT_BAR();
            { const AttnItem<D> it = ATT_ITEM(id); ATT_S_SOFTMAX(it); }
            ATT_WAIT0(); ATT_BAR();
            { const AttnItem<D> it = ATT_ITEM(id); ATT_ISSUE_V(it); }
            ATT_WAIT0(); ATT_BAR();
            { const AttnItem<D> it = ATT_ITEM(id); ATT_PV_STORE(it); }
            ATT_WAIT0(); ATT_BAR();
        }
    }
#undef ATT_ITEM
#undef ATT_QFENCE
    ATT_WAIT0(); ATT_BAR();
#undef ATT_ISSUE_K
#undef ATT_ISSUE_V
#undef ATT_LOAD_Q
#undef ATT_S_SOFTMAX
#undef ATT_PV_STORE
}

__device__ __forceinline__ void pool_phase(Frame& F, const bf16* U, bf16* POOLED) {
    const int lane = lane_id();
    const int gw = F.vcu * NWAVES + F.wave, NGW = F.G * NWAVES;
    constexpr int NTC = SEQ / 64, NCC = POOLW / 512, NIT = BATCH * NTC * NCC;
    for (int itx = gw; itx < NIT; itx += NGW) {
        const int cc = itx % NCC, tc = (itx / NCC) % NTC, b = itx / (NCC * NTC);
        const int col = 512 * cc + 8 * lane, w = 2 << (col / POOLG);
        const int t0 = 64 * tc, ts = t0 >= 16 ? t0 - 16 : 0;
        const bf16* ub = U + (size_t)b * SEQ * DM + col;
        bf16* pb = POOLED + (size_t)b * SEQ * DM + col;
        float S[8];
#pragma unroll
        for (int j = 0; j < 8; ++j) S[j] = 0.f;
#pragma unroll 8
        for (int t = ts; t < t0 + 64; ++t) {
            const v4u cur = *(const GAS v4u*)(ub + (size_t)t * DM);
            const int to = (t - w >= ts) ? t - w : t; const float sg = (t - w >= ts) ? 1.f : 0.f;
            const v4u old = *(const GAS v4u*)(ub + (size_t)to * DM);
            float cv[8] = {bflo(cur.x), bfhi(cur.x), bflo(cur.y), bfhi(cur.y), bflo(cur.z), bfhi(cur.z), bflo(cur.w), bfhi(cur.w)};
            float ov[8] = {bflo(old.x), bfhi(old.x), bflo(old.y), bfhi(old.y), bflo(old.z), bfhi(old.z), bflo(old.w), bfhi(old.w)};
#pragma unroll
            for (int j = 0; j < 8; ++j) S[j] += cv[j] - sg * ov[j];
            if (t >= t0) { const float ic = 1.0f / (float)((t + 1) < w ? (t + 1) : w); v4u o;
                o.x = pk2(S[0] * ic - cv[0], S[1] * ic - cv[1]); o.y = pk2(S[2] * ic - cv[2], S[3] * ic - cv[3]); o.z = pk2(S[4] * ic - cv[4], S[5] * ic - cv[5]); o.w = pk2(S[6] * ic - cv[6], S[7] * ic - cv[7]);
                *(GAS v4u*)(pb + (size_t)t * DM) = o; }
        }
    }
}
__device__ __forceinline__ void merge_phase(Frame& F, const bf16* OG, const float* LSE, unsigned char* CAT2) {
    const int gw = F.vcu * NWAVES + F.wave, NGW = F.G * NWAVES;
    const int lane = lane_id(), h = lane >> 3, col = h * 128 + 16 * (lane & 7);
    for (int row = gw; row < M; row += NGW) {
        const float* lp = LSE + (size_t)row * 24 + h * 3;
        const float l0 = lp[0], l1 = lp[1], l2 = lp[2];
        const float mx = fmaxf(l0, fmaxf(l1, l2));
        float w0 = __expf(l0 - mx), w1 = __expf(l1 - mx), w2 = __expf(l2 - mx); const float inv = 1.0f / (w0 + w1 + w2); w0 *= inv; w1 *= inv; w2 *= inv;
        float acc[16];
#pragma unroll
        for (int j = 0; j < 16; ++j) acc[j] = 0.f;
#pragma unroll
        for (int g = 0; g < 3; ++g) { const float wg = g == 0 ? w0 : (g == 1 ? w1 : w2); const bf16* src = OG + (size_t)g * M * 1024 + (size_t)row * 1024 + col;
#pragma unroll
            for (int hh = 0; hh < 2; ++hh) { const v4u x = *(const GAS v4u*)(src + 8 * hh);
                acc[8 * hh + 0] += wg * bflo(x.x); acc[8 * hh + 1] += wg * bfhi(x.x); acc[8 * hh + 2] += wg * bflo(x.y); acc[8 * hh + 3] += wg * bfhi(x.y);
                acc[8 * hh + 4] += wg * bflo(x.z); acc[8 * hh + 5] += wg * bfhi(x.z); acc[8 * hh + 6] += wg * bflo(x.w); acc[8 * hh + 7] += wg * bfhi(x.w); } }
        v4u o;
        { int p = __builtin_amdgcn_cvt_pk_fp8_f32(acc[0] * 16.f, acc[1] * 16.f, 0, false); p = __builtin_amdgcn_cvt_pk_fp8_f32(acc[2] * 16.f, acc[3] * 16.f, p, true); o.x = (unsigned)p; }
        { int p = __builtin_amdgcn_cvt_pk_fp8_f32(acc[4] * 16.f, acc[5] * 16.f, 0, false); p = __builtin_amdgcn_cvt_pk_fp8_f32(acc[6] * 16.f, acc[7] * 16.f, p, true); o.y = (unsigned)p; }
        { int p = __builtin_amdgcn_cvt_pk_fp8_f32(acc[8] * 16.f, acc[9] * 16.f, 0, false); p = __builtin_amdgcn_cvt_pk_fp8_f32(acc[10] * 16.f, acc[11] * 16.f, p, true); o.z = (unsigned)p; }
        { int p = __builtin_amdgcn_cvt_pk_fp8_f32(acc[12] * 16.f, acc[13] * 16.f, 0, false); p = __builtin_amdgcn_cvt_pk_fp8_f32(acc[14] * 16.f, acc[15] * 16.f, p, true); o.w = (unsigned)p; }
        *(GAS v4u*)(CAT2 + (size_t)row * 2048 + col) = o;
    }
}
__device__ __forceinline__ void w2q_colsum_phase(Frame& F, const unsigned char* W2Q, int* CS) {
    const int gw = F.vcu * NWAVES + F.wave, NGW = F.G * NWAVES, lane = lane_id();
    for (int n = gw; n < DM; n += NGW) {
        const GAS v4u* p = (const GAS v4u*)(W2Q + (size_t)n * DFF) + lane;
        v4u x[16];
#pragma unroll
        for (int j = 0; j < 16; ++j) x[j] = p[64 * j];
        int s = 0;
#define W2Q_BSUM(u) { const int w = (int)(u); s += ((w << 24) >> 24) + ((w << 16) >> 24) + ((w << 8) >> 24) + (w >> 24); }
#pragma unroll
        for (int j = 0; j < 16; ++j) { W2Q_BSUM(x[j].x) W2Q_BSUM(x[j].y) W2Q_BSUM(x[j].z) W2Q_BSUM(x[j].w) }
#undef W2Q_BSUM
#pragma unroll
        for (int o = 1; o < 64; o <<= 1) s += __shfl_xor(s, o);
        if (lane == 0) CS[n] = 128 * s;
    }
}
__device__ __forceinline__ void final_norm_phase(Frame& F, const bf16* XB, float* out, const float* gain, const int* evcnt, const int* ev, const float* W2f) {
    const int gw = F.vcu * NWAVES + F.wave, NGW = F.G * NWAVES, lane = lane_id();
    for (int row = gw; row < M; row += NGW) {
        const GAS v4u* xr = (const GAS v4u*)(XB + (size_t)row * DM) + lane; GAS f32x4* orow = (GAS f32x4*)(out + (size_t)row * DM) + 2 * lane; const GAS f32x4* gr = (const GAS f32x4*)gain + 2 * lane;
        v4u x[8];
#pragma unroll
        for (int j = 0; j < 8; ++j) x[j] = xr[64 * j];
        int cnt = __builtin_amdgcn_readfirstlane(evcnt[row]); cnt = cnt < pg8::EV_MAX ? cnt : pg8::EV_MAX;
        f32x4 o0[8], o1[8];
#pragma unroll
        for (int j = 0; j < 8; ++j) { o0[j] = (f32x4){bflo(x[j].x), bfhi(x[j].x), bflo(x[j].y), bfhi(x[j].y)}; o1[j] = (f32x4){bflo(x[j].z), bfhi(x[j].z), bflo(x[j].w), bfhi(x[j].w)}; }
        if (cnt > 0) {
            const int ek = lane < cnt ? ev[((size_t)row * pg8::EV_MAX + lane) * 2] : 0x7fffffff; const float ee = lane < cnt ? __builtin_bit_cast(float, ev[((size_t)row * pg8::EV_MAX + lane) * 2 + 1]) : 0.f;
            int rank = 0;
#pragma unroll
            for (int j = 0; j < pg8::EV_MAX; ++j) rank += (__shfl(ek, j) < ek) ? 1 : 0;
            for (int a = 0; a < cnt; ++a) {
                const unsigned long long mask = __ballot(lane < cnt && rank == a); const int src = __builtin_ctzll(mask);
                const int k = __shfl(ek, src); const float e = __shfl(ee, src);
                const GAS f32x4* wr = (const GAS f32x4*)(W2f + (size_t)k * DM) + 2 * lane;
#pragma unroll
                for (int j = 0; j < 8; ++j) { const f32x4 w0 = wr[128 * j], w1 = wr[128 * j + 1]; o0[j] += w0 * e; o1[j] += w1 * e; }
            }
        }
        float s = 0.f;
#pragma unroll
        for (int j = 0; j < 8; ++j) s += (o0[j].x * o0[j].x + o0[j].y * o0[j].y) + (o0[j].z * o0[j].z + o0[j].w * o0[j].w) + (o1[j].x * o1[j].x + o1[j].y * o1[j].y) + (o1[j].z * o1[j].z + o1[j].w * o1[j].w);
        s = wave_sum(s);
        const float r = __builtin_amdgcn_rsqf(s * (1.0f / 4096.0f) + pg8::RMS_EPS);
#pragma unroll
        for (int j = 0; j < 8; ++j) { const f32x4 g0 = gr[128 * j], g1 = gr[128 * j + 1]; orow[128 * j] = o0[j] * r * g0; orow[128 * j + 1] = o1[j] * r * g1; }
    }
}

struct MemMaker { const bf16* Qsrc; int ldq, qcol0; const bf16* MKV; int l; bf16* Odst; int ldo, ocol0; unsigned char* Odst8;
    __device__ __forceinline__ AttnItem<256> operator()(int id) const {
        const int qt = id % (SEQ / 128), h = (id / (SEQ / 128)) % 4, b = id / (4 * (SEQ / 128));
        AttnItem<256> it;
        it.q = Qsrc + (size_t)(b * SEQ + 128 * qt) * ldq + qcol0 + h * 256; it.qstride = (size_t)ldq;
        it.k = MKV + (size_t)(b * MEMLEN) * DM + l * 2048 + h * 256; it.v = it.k + 1024; it.kstride = DM; it.key_lo = 0;
        it.o = Odst + (size_t)(b * SEQ + 128 * qt) * ldo + ocol0 + h * 256; it.ostride = (size_t)ldo; it.lse = nullptr; it.lse_stride = 0; it.bias = nullptr;
        it.o8 = Odst8 ? Odst8 + (size_t)(b * SEQ + 128 * qt) * ldo + ocol0 + h * 256 : nullptr;
        return it; } };
__device__ __forceinline__ void memattn_phase(Frame& F, const bf16* Qsrc, int ldq, int qcol0, const bf16* MKV, int l, bf16* Odst, int ldo, int ocol0, unsigned char* Odst8) {
    const MemMaker mk{Qsrc, ldq, qcol0, MKV, l, Odst, ldo, ocol0, Odst8};
    attn_run<256, false>(F.lds + RING_OFF, mk, F.vcu, F.G, BATCH * 4 * (SEQ / 128), F.wave);
}
struct DilMaker { const bf16* KVU; bf16* OG; float* LSE; const float* BT;
    __device__ __forceinline__ AttnItem<128> operator()(int id) const {
        const int j = id & 15, g = (id >> 4) % 3, h = ((id >> 4) / 3) & 7, b = (id >> 4) / 24;
        const int dil = g == 0 ? 1 : (g == 1 ? 4 : 16), r = g == 0 ? 0 : (g == 1 ? (j >> 2) : j), n = g == 0 ? j : (g == 1 ? (j & 3) : 0);
        AttnItem<128> it;
        const size_t rs = (size_t)dil * KVUW;
        const long row_q0 = (long)b * SEQ + (long)(128 * n) * dil + r;
        it.q = KVU + (size_t)row_q0 * KVUW + KVW + g * 1024 + h * 128; it.qstride = rs;
        const bf16* kq0 = KVU + (size_t)row_q0 * KVUW + g * 1024 + h * 128;
        it.k = kq0 - 128 * rs; it.v = it.k + 3072; it.kstride = rs; it.key_lo = n == 0 ? 128 : 0;
        it.o = OG + (size_t)g * M * 1024 + (size_t)row_q0 * 1024 + h * 128; it.ostride = (size_t)dil * 1024; it.o8 = nullptr;
        it.lse = LSE + (size_t)row_q0 * 24 + h * 3 + g; it.lse_stride = dil * 24; it.bias = BT + (g * 8 + h) * 129;
        return it; } };
__device__ __forceinline__ void dilattn_phase(Frame& F, const bf16* KVU, bf16* OG, float* LSE, const float* BT) {
    const DilMaker mk{KVU, OG, LSE, BT};
    attn_run<128, true>(F.lds + RING_OFF, mk, F.vcu, F.G, BATCH * 8 * 3 * 16, F.wave);
}

struct Args { const float* in[19]; float* out; unsigned char* ws; int ph_lo, ph_hi, li, pad; };
constexpr int N_STEPS = 14;
typedef const Args __attribute__((address_space(4))) CArgs;
__device__ __forceinline__ CArgs* kargs() { CArgs* p = (CArgs*)__builtin_amdgcn_kernarg_segment_ptr(); asm volatile("" : "+s"(p)); return p; }
#ifndef MK_ONLY
#define MK_ONLY -1
#endif
#define STEP_ON(k) (MK_ONLY < 0 || MK_ONLY == (k))

template <int L> __device__ __forceinline__ void step_inproj(Frame& F) {
    CArgs* ap = kargs(); unsigned char* ws = ap->ws;
    if constexpr (L == 0) {
        pg8::Gemm g; g.A = (const bf16*)(ws + WS_XB); g.Bt = (const bf16*)(ws + WS_WAIN); g.M = M; g.N = DM; g.K = DM; g.lda = DM; g.ldb = DM; g.npg = 0; g.a_gstride = 0;
        pg8::StaticOrder S; S.init(g.M, g.N, F.G, (int)blockIdx.x);
        pg8::EpiScaleBf16<0> E{nullptr, nullptr, (bf16*)(ws + WS_U), DM, (const pg8::ssq_t*)(ws + WS_SSQ0), 1.0f};
        pg8::gemm_phase<pg8::EpiScaleBf16<0>, pg8::StaticOrder, PG8_ALIGN, PG8_SP2>(F.lds + RING_OFF, g, S, E, F.wave);
    } else {
        pg8::Gemm g; g.A = (const bf16*)(ws + WS_XB8); g.Bt = (const bf16*)(ws + WS_WKVB); g.M = M; g.N = KVUW; g.K = DM / 2; g.lda = DM / 2; g.ldb = DM / 2; g.npg = 0; g.a_gstride = 0;
        pg8::StaticOrder S; S.init(g.M, g.N, F.G, (int)blockIdx.x);
        pg8::EpiScaleBf16<0, true> E{nullptr, nullptr, (bf16*)(ws + WS_KVU), KVUW, (const pg8::ssq_t*)(ws + WS_CTL + CTL_SS) + 1 * M, pg8::X2_RMS_RATIO / (pg8::I8_SA * pg8::I8_SW), (const pg8::ssq_t*)(ws + WS_CTL + CTL_SS) + 0 * M};
        pg8::gemm_phase<pg8::EpiScaleBf16<0, true>, pg8::StaticOrder, PG8_ALIGN, PG8_SP2, false, true>(F.lds + RING_OFF, g, S, E, F.wave);
    }
    const int Gh = F.G / 2;
    if (L == 0 && (int)blockIdx.x < Gh) {
        pg8::Gemm g; g.A = (const bf16*)(ws + WS_MEMB); g.Bt = (const bf16*)(ws + WS_WMEMKV); g.M = MMEM; g.N = DM; g.K = DM / 2; g.lda = DM / 2; g.ldb = DM / 2; g.npg = 0; g.a_gstride = 0;
        pg8::StaticOrder S; S.init(g.M, g.N, Gh, (int)blockIdx.x);
        pg8::EpiScaleBf16<0, true> E{nullptr, nullptr, (bf16*)(ws + WS_MKV), DM, nullptr, 1.0f / (pg8::I8_SA * pg8::I8_SW), nullptr};
        pg8::gemm_phase<pg8::EpiScaleBf16<0, true>, pg8::StaticOrder, PG8_ALIGN, PG8_SP2, false, true>(F.lds + RING_OFF, g, S, E, F.wave);
    }
    if (L == 0 && (int)blockIdx.x >= Gh) {
        pg8::Gemm g; g.A = (const bf16*)(ws + WS_WOUTP); g.Bt = (const bf16*)(ws + WS_WPG); g.M = DM; g.N = POOLW; g.K = POOLG; g.lda = POOLW; g.ldb = POOLG; g.npg = 3; g.a_gstride = POOLG * 2;
        pg8::StaticOrder S; S.init(g.M, g.N, F.G - Gh, (int)blockIdx.x - Gh);
        pg8::EpiScaleBf16<0> E{nullptr, nullptr, (bf16*)(ws + WS_WAOUT), DM, nullptr, 1.0f};
        pg8::gemm_phase<pg8::EpiScaleBf16<0>, pg8::StaticOrder, PG8_ALIGN, PG8_SP2>(F.lds + RING_OFF, g, S, E, F.wave);
    }
}
template <int L> __device__ __forceinline__ void step_mixer(Frame& F) {
    CArgs* ap = kargs(); unsigned char* ws = ap->ws;
    if (L == 0) {
        pool_phase(F, (const bf16*)(ws + WS_U), (bf16*)(ws + WS_CAT));
        memattn_phase(F, (const bf16*)(ws + WS_U), DM, POOLW, (const bf16*)(ws + WS_MKV), 0, (bf16*)(ws + WS_CAT), DM, POOLW, nullptr);
    } else {
        dilattn_phase(F, (const bf16*)(ws + WS_KVU), (bf16*)(ws + WS_OG), (float*)(ws + WS_LSE), (const float*)(ws + WS_SS0 + 131072));
        memattn_phase(F, (const bf16*)(ws + WS_KVU), KVUW, KVW + 3072, (const bf16*)(ws + WS_MKV), 1, nullptr, 2048, 1024, ws + WS_CAT2);
    }
}
template <int L> __device__ __forceinline__ void step_mix2(Frame& F) {
    CArgs* ap = kargs(); unsigned char* ws = ap->ws;
    if (L == 0) {
    } else {
        w2q_colsum_phase(F, ws + WS_W2 + (size_t)DM * DFF * 2, (int*)(ws + WS_SS0));
        merge_phase(F, (const bf16*)(ws + WS_OG), (const float*)(ws + WS_LSE), ws + WS_CAT2);
    }
}
template <int L> __device__ __forceinline__ void step_outproj(Frame& F) {
    CArgs* ap = kargs(); unsigned char* ws = ap->ws;
    pg8::StaticOrder S; S.init(M, DM, F.G, (int)blockIdx.x);
    if constexpr (L == 0) {
        pg8::Gemm g; g.A = (const bf16*)(ws + WS_CAT); g.Bt = (const bf16*)(ws + WS_WAOUT); g.M = M; g.N = DM; g.K = DM; g.lda = DM; g.ldb = DM; g.npg = 0; g.a_gstride = 0;
        pg8::EpiResid<2> E{(const bf16*)(ws + WS_XB), (bf16*)(ws + WS_XB), (pg8::ssq_t*)(ws + WS_CTL + CTL_SS) + 0 * M, ws + WS_XB8, 1.0f, (const pg8::ssq_t*)(ws + WS_SSQ0), pg8::I8_SA / pg8::X1_RMS_RATIO, nullptr};
        pg8::gemm_phase<pg8::EpiResid<2>, pg8::StaticOrder, PG8_ALIGN, PG8_SP2>(F.lds + RING_OFF, g, S, E, F.wave);
    } else {
        pg8::Gemm g; g.A = (const bf16*)(ws + WS_CAT2); g.Bt = (const bf16*)(ws + WS_WBOUT); g.M = M; g.N = DM; g.K = 1024; g.lda = 1024; g.ldb = 1024; g.npg = 0; g.a_gstride = 0;
        pg8::EpiResid<2> E{(const bf16*)(ws + WS_XB), (bf16*)(ws + WS_XB), (pg8::ssq_t*)(ws + WS_CTL + CTL_SS) + 2 * M, ws + WS_XB8, 1.0f / 1024.0f, (const pg8::ssq_t*)(ws + WS_CTL + CTL_SS) + 1 * M, pg8::I8_SA, nullptr};
        pg8::gemm_phase<pg8::EpiResid<2>, pg8::StaticOrder, PG8_ALIGN, PG8_SP2, true>(F.lds + RING_OFF, g, S, E, F.wave);
    }
}
template <int L> __device__ __forceinline__ void step_mlp1(Frame& F) {
    CArgs* ap = kargs(); unsigned char* ws = ap->ws;
    if constexpr (L == 0) {
    {
    pg8::Gemm g; g.A = (const bf16*)(ws + WS_XB8); g.Bt = (const bf16*)(ws + WS_W1); g.M = M; g.N = NQ0; g.K = DM / 2; g.lda = DM / 2; g.ldb = DM / 2; g.npg = 0; g.a_gstride = 0;
    pg8::StaticOrder S; S.init(g.M, g.N, F.G, (int)blockIdx.x);
    pg8::EpiScaleBf16<1, true> E{nullptr, nullptr, (bf16*)(ws + WS_HID), DFF, (const pg8::ssq_t*)(ws + WS_CTL + CTL_SS) + 0 * M, pg8::X1_RMS_RATIO / (pg8::I8_SA * pg8::I8_SW), (const pg8::ssq_t*)(ws + WS_SSQ0)};
    pg8::gemm_phase<pg8::EpiScaleBf16<1, true>, pg8::StaticOrder, PG8_ALIGN, PG8_SP2, false, true>(F.lds + RING_OFF, g, S, E, F.wave);
    }
    if constexpr (NQ0 < DFF) {
    pg8::Gemm g; g.A = (const bf16*)(ws + WS_XB); g.Bt = (const bf16*)(ws + WS_W1 + 64 * MiB); g.M = M; g.N = DFF - NQ0; g.K = DM; g.lda = DM; g.ldb = DM; g.npg = 0; g.a_gstride = 0;
    pg8::StaticOrder S; S.init(g.M, g.N, F.G, (int)blockIdx.x);
    pg8::EpiScaleBf16<1> E{nullptr, nullptr, (bf16*)(ws + WS_HID) + NQ0, DFF, (const pg8::ssq_t*)(ws + WS_CTL + CTL_SS) + 0 * M, 1.0f, nullptr};
    pg8::gemm_phase<pg8::EpiScaleBf16<1>, pg8::StaticOrder, PG8_ALIGN, PG8_SP2>(F.lds + RING_OFF, g, S, E, F.wave);
    }
    } else {
    pg8::Gemm g; g.A = (const bf16*)(ws + WS_XB8); g.Bt = (const bf16*)(ws + WS_W1) + (size_t)DFF * DM; g.M = M; g.N = DFF; g.K = DM / 2; g.lda = DM / 2; g.ldb = DM / 2; g.npg = 0; g.a_gstride = 0;
    pg8::StaticOrder S; S.init(g.M, g.N, F.G, (int)blockIdx.x);
    pg8::EpiScaleBf16<1, true, 1> E{(int*)(ws + WS_CTL + CTL_EVCNT), (int*)(ws + WS_EV), (bf16*)(ws + WS_HID), DFF, (const pg8::ssq_t*)(ws + WS_CTL + CTL_SS) + 2 * M, 1.0f / (pg8::I8_SA * pg8::I8_SW), (const pg8::ssq_t*)(ws + WS_CTL + CTL_SS) + 1 * M};
    pg8::gemm_phase<pg8::EpiScaleBf16<1, true, 1>, pg8::StaticOrder, PG8_ALIGN, PG8_SP2, false, true>(F.lds + RING_OFF, g, S, E, F.wave);
    }
}
template <int L> __device__ __forceinline__ void step_mlp2(Frame& F) {
    CArgs* ap = kargs(); unsigned char* ws = ap->ws;
    if constexpr (L == 0) {
    pg8::Gemm g; g.A = (const bf16*)(ws + WS_HID); g.Bt = (const bf16*)(ws + WS_W2); g.M = M; g.N = DM; g.K = DFF; g.lda = DFF; g.ldb = DFF; g.npg = 0; g.a_gstride = 0;
    pg8::StaticOrder S; S.init(g.M, g.N, F.G, (int)blockIdx.x);
    pg8::EpiResid<2> E{(const bf16*)(ws + WS_XB), (bf16*)(ws + WS_XB), (pg8::ssq_t*)(ws + WS_CTL + CTL_SS) + 1 * M, (unsigned char*)(ws + WS_XB8), 1.0f, (const pg8::ssq_t*)(ws + WS_CTL + CTL_SS) + 0 * M, pg8::I8_SA / pg8::X2_RMS_RATIO, nullptr};
    pg8::gemm_phase<pg8::EpiResid<2>, pg8::StaticOrder, PG8_ALIGN, PG8_SP2>(F.lds + RING_OFF, g, S, E, F.wave);
    } else {
    pg8::Gemm g; g.A = (const bf16*)(ws + WS_HID); g.Bt = (const bf16*)(ws + WS_W2) + (size_t)DM * DFF; g.M = M; g.N = DM; g.K = DFF / 2; g.lda = DFF / 2; g.ldb = DFF / 2; g.npg = 0; g.a_gstride = 0;
    pg8::StaticOrder S; S.init(g.M, g.N, F.G, (int)blockIdx.x);
    pg8::EpiResid<0, true> E{(const bf16*)(ws + WS_XB), (bf16*)(ws + WS_XB), (pg8::ssq_t*)(ws + WS_CTL + CTL_SS) + 3 * M, nullptr, pg8::HQ_R / (255.0f * pg8::I8_SW2), nullptr, 0.f, (const int*)(ws + WS_SS0)};
    pg8::gemm_phase<pg8::EpiResid<0, true>, pg8::StaticOrder, PG8_ALIGN, PG8_SP2, false, true>(F.lds + RING_OFF, g, S, E, F.wave);
    }
}

__global__ void __launch_bounds__(NWAVES * 64, 2) yoco_fwd(Args args) {
    extern __shared__ __attribute__((aligned(16))) unsigned char lds[];
    Frame F;
    F.lds = (LAS unsigned char*)lds;
    F.MISC = (volatile LAS unsigned*)(F.lds + MISC_OFF);
    F.wave = __builtin_amdgcn_readfirstlane((int)threadIdx.x >> 6);
    F.G = gridDim.x; { const int bx = blockIdx.x; F.vcu = (F.G % 8 == 0) ? (bx % 8) * (F.G / 8) + bx / 8 : bx; }
    F.ctl = (gu32*)(kargs()->ws + WS_CTL);
    for (int u = F.wave * 64 + lane_id(); u < (LDS_BYTES - LDSCTL_OFF) / 4; u += NWAVES * 64) ((LAS unsigned*)(F.lds + LDSCTL_OFF))[u] = 0u;
    __syncthreads();
    XcdBarrier bar; bar.bar = (unsigned*)(F.ctl + CW_BAR); bar.x = 0; bar.st = nullptr;
#define LEADER() (F.wave == 0 && lane_id() == 0)
    if (!MK_PER_PHASE) bar = xcd_barrier_post((unsigned*)(F.ctl + CW_BAR), F.MISC + 8, LEADER());
#define GRID_BAR() do { if (MK_PER_PHASE) { if (LEADER()) __hip_atomic_store(F.ctl + CW_TMO, 0xBADBA0u, RLX_AGENT); } else { xcd_barrier(bar, LEADER()); } } while (0)
#define LO (kargs()->ph_lo)
#define HI (kargs()->ph_hi)
#define IN(k) (STEP_ON(k) && LO <= (k) && (k) < HI)
#define SEAM(k) do { if (LO <= (k) && (k) + 1 < HI) GRID_BAR(); } while (0)

    if (IN(0)) { CArgs* ap = kargs(); Ptrs P;
        P.x = ap->in[0]; P.mem = ap->in[1]; P.a_norm = ap->in[2]; P.a_w_in = ap->in[3]; P.a_w_pg = ap->in[4]; P.a_scale = ap->in[5]; P.a_w_out = ap->in[6]; P.kv_norm = ap->in[7]; P.w_kv = ap->in[8];
        P.b_norm = ap->in[9]; P.b_w_in = ap->in[10]; P.b_w_out = ap->in[11]; P.mem_norm = ap->in[12]; P.w_mem_kv = ap->in[13]; P.mlp_norm = ap->in[14]; P.mlp_w1 = ap->in[15]; P.mlp_w2 = ap->in[16];
        P.rel_bias = ap->in[17]; P.final_norm = ap->in[18];
        p0_prologue(F, P, ap->ws); }
    SEAM(0);
    if (IN(1)) step_inproj<0>(F);
    SEAM(1);
    if (IN(2)) step_mixer<0>(F);
    SEAM(2);
    if (IN(4)) step_outproj<0>(F);
    SEAM(4);
    if (IN(5)) step_mlp1<0>(F);
    SEAM(5);
    if (IN(6)) step_mlp2<0>(F);
    SEAM(6);
    if (IN(7)) step_inproj<1>(F);
    SEAM(7);
    if (IN(8)) step_mixer<1>(F);
    SEAM(8);
    if (IN(9)) step_mix2<1>(F);
    SEAM(9);
    if (IN(10)) step_outproj<1>(F);
    SEAM(10);
    if (IN(11)) step_mlp1<1>(F);
    SEAM(11);
    if (IN(12)) step_mlp2<1>(F);
    SEAM(12);
    if (IN(13)) { CArgs* ap = kargs(); final_norm_phase(F, (const bf16*)(ap->ws + WS_XB), ap->out, ap->in[18], (const int*)(ap->ws + WS_CTL + CTL_EVCNT), (const int*)(ap->ws + WS_EV), ap->in[16] + (size_t)DFF * DM); }
#undef IN
#undef SEAM
}

extern "C" void kernel_launch(void* const* d_in, const int* in_sizes, int n_in, void* d_out, int out_size, void* d_ws, size_t ws_size, hipStream_t stream) {
    static int grid = 0;
    if (grid == 0) {
        if (n_in != 19 || in_sizes[0] != M * DM || out_size != M * DM || ws_size < WS_END) { fprintf(stderr, "kernel_launch: unexpected shapes (n_in %d, in0 %d, out %d, ws %zu); nothing launched\n", n_in, n_in > 0 ? in_sizes[0] : -1, out_size, ws_size); grid = -1; return; }
        int dev = 0, cus = 0, per_cu = 0;
        if (hipGetDevice(&dev) != hipSuccess || hipDeviceGetAttribute(&cus, hipDeviceAttributeMultiprocessorCount, dev) != hipSuccess) { fprintf(stderr, "kernel_launch: device query failed\n"); grid = -1; return; }
        if (hipFuncSetAttribute((const void*)yoco_fwd, hipFuncAttributeMaxDynamicSharedMemorySize, LDS_BYTES) != hipSuccess) { fprintf(stderr, "kernel_launch: hipFuncSetAttribute failed\n"); grid = -1; return; }
        if (hipOccupancyMaxActiveBlocksPerMultiprocessor(&per_cu, (const void*)yoco_fwd, NWAVES * 64, LDS_BYTES) != hipSuccess || per_cu < 1)
            fprintf(stderr, "kernel_launch: note: occupancy query reports %d workgroups per CU\n", per_cu);
        (void)hipGetLastError();
        grid = cus;
    }
    if (grid < 0) return;
    if (hipMemsetAsync((char*)d_ws + WS_CTL, 0, CTL_ZERO_BYTES, stream) != hipSuccess) { fprintf(stderr, "kernel_launch: memset failed\n"); return; }
    Args a{};
    for (int i = 0; i < 19; ++i) a.in[i] = (const float*)d_in[i];
    a.out = (float*)d_out; a.ws = (unsigned char*)d_ws;
#if MK_PER_PHASE
    for (int li = 0; li < N_STEPS; ++li) { a.ph_lo = li; a.ph_hi = li + 1; a.li = li;
        hipLaunchKernelGGL(yoco_fwd, dim3(grid), dim3(NWAVES * 64), LDS_BYTES, stream, a); }
#else
    a.ph_lo = 0; a.ph_hi = N_STEPS; a.li = 0;
    hipLaunchKernelGGL(yoco_fwd, dim3(grid), dim3(NWAVES * 64), LDS_BYTES, stream, a);
#endif
    const hipError_t le = hipPeekAtLastError();
    if (le != hipSuccess) fprintf(stderr, "kernel_launch: launch failed: %s\n", hipGetErrorName(le));
}
```
